# Optimizing an MI355X kernel written in HIP

```python
import math
import jax, jax.numpy as jnp
from jax import lax
import numpy as np

D_MODEL = 1024
BATCH = 32
SEQ = 2048
DEPTH = 1

N_Q_HEADS = 8
N_KV_HEADS = 2
HEAD_DIM = 64
GQA_GROUP = N_Q_HEADS // N_KV_HEADS
ATTN_WIDTH = N_Q_HEADS * HEAD_DIM
KV_WIDTH = N_KV_HEADS * HEAD_DIM
WINDOW = 128
BLOCK = 128
N_BUCKETS = 32
MAX_DISTANCE = 128
POOL_WINDOWS = (2, 4, 8, 16)
N_POOL_GROUPS = len(POOL_WINDOWS)
POOL_WIDTH = D_MODEL // 2
POOL_GROUP_DIM = POOL_WIDTH // N_POOL_GROUPS
MIX_WIDTH = ATTN_WIDTH + POOL_WIDTH
IN_WIDTH = ATTN_WIDTH + 2 * KV_WIDTH + POOL_WIDTH
D_FF = 2816
MACARON_WEIGHT = 0.5
PLE_DIM = 256
EPS = 1e-6
NEG_INF = -1e30

kernel_name = "hybrid_swa_sink_pool_macaron_ple"


def rms_norm(x, gain):
    xf = x.astype(jnp.float32)
    y = xf * lax.rsqrt(jnp.mean(xf * xf, axis=-1, keepdims=True) + EPS)
    return (y * gain.astype(jnp.float32)).astype(x.dtype)


def swiglu(h, w_gu, w_down):
    g, u = jnp.split(h @ w_gu, 2, axis=-1)
    return (jax.nn.silu(g) * u) @ w_down


def t5_bucket(dist):
    n = jnp.maximum(dist, 0)
    max_exact = N_BUCKETS // 2
    nf = jnp.maximum(n, 1).astype(jnp.float32)
    large = max_exact + (jnp.log(nf / max_exact) / math.log(MAX_DISTANCE / max_exact)
                         * (N_BUCKETS - max_exact)).astype(jnp.int32)
    large = jnp.minimum(large, N_BUCKETS - 1)
    return jnp.where(n < max_exact, n, large)


def sliding_window_attention(q, k, v, rel_bias, sinks):
    B, S = q.shape[0], q.shape[1]
    nb = S // BLOCK
    q = q.reshape(B, nb, BLOCK, N_KV_HEADS, GQA_GROUP, HEAD_DIM)
    k = k.reshape(B, nb, BLOCK, N_KV_HEADS, HEAD_DIM)
    v = v.reshape(B, nb, BLOCK, N_KV_HEADS, HEAD_DIM)
    pad = ((0, 0), (1, 0), (0, 0), (0, 0), (0, 0))
    k_ctx = jnp.concatenate([jnp.pad(k, pad)[:, :-1], k], axis=2)
    v_ctx = jnp.concatenate([jnp.pad(v, pad)[:, :-1], v], axis=2)
    scores = jnp.einsum('bnqhgd,bnkhd->bnhgqk', q, k_ctx).astype(jnp.float32)
    scores = scores * (1.0 / math.sqrt(HEAD_DIM))
    qi = jnp.arange(BLOCK)[:, None]
    kj = jnp.arange(2 * BLOCK)[None, :]
    dist = qi + BLOCK - kj
    bias = rel_bias[t5_bucket(dist)]
    bias = jnp.transpose(bias, (2, 0, 1)).reshape(
        N_KV_HEADS, GQA_GROUP, BLOCK, 2 * BLOCK).astype(jnp.float32)
    key_pos = jnp.arange(nb)[:, None, None] * BLOCK - BLOCK + kj[None]
    valid = ((dist >= 0) & (dist < WINDOW))[None] & (key_pos >= 0)
    scores = jnp.where(valid[None, :, None, None], scores + bias, NEG_INF)
    sink = jnp.broadcast_to(
        sinks.astype(jnp.float32).reshape(N_KV_HEADS, GQA_GROUP)[None, None, :, :, None, None],
        scores.shape[:-1] + (1,))
    probs = jax.nn.softmax(jnp.concatenate([scores, sink], axis=-1), axis=-1)[..., :-1]
    out = jnp.einsum('bnhgqk,bnkhd->bnqhgd', probs.astype(v.dtype), v_ctx)
    return out.reshape(B, S, ATTN_WIDTH)


def multiscale_pool(u, pool_w, pool_scale):
    B, S, _ = u.shape
    uf = u.astype(jnp.float32)
    c = jnp.pad(jnp.cumsum(uf, axis=1), ((0, 0), (1, 0), (0, 0)))
    t = jnp.arange(S)
    means = []
    for g, w in enumerate(POOL_WINDOWS):
        cg = c[..., g * POOL_GROUP_DIM:(g + 1) * POOL_GROUP_DIM]
        lo = jnp.maximum(t + 1 - w, 0)
        s = cg[:, 1:] - jnp.take(cg, lo, axis=1)
        cnt = (t + 1 - lo).astype(jnp.float32)[None, :, None]
        means.append(s / cnt)
    mean = jnp.stack(means, axis=2)
    d = (mean - uf.reshape(B, S, N_POOL_GROUPS, POOL_GROUP_DIM)).astype(u.dtype)
    y = jnp.einsum('bsgc,gcd->bsgd', d, pool_w).reshape(B, S, POOL_WIDTH)
    return y * pool_scale


def setup_inputs(seed: int = 0) -> dict:
    key = jax.random.key(seed)
    ks = jax.random.split(key, 24)
    f32 = jnp.float32

    def nrm(k, shape, scale):
        return jax.random.normal(k, shape, f32) * scale

    def gain(k, shape):
        return 1.0 + 0.05 * jax.random.normal(k, shape, f32)

    L = DEPTH
    return {
        "x": nrm(ks[0], (BATCH, SEQ, D_MODEL), 1.0),
        "p": nrm(ks[1], (DEPTH, BATCH, SEQ, PLE_DIM), 1.0),
        "ffn1_norm": gain(ks[2], (L, D_MODEL)),
        "ffn1_w_gu": nrm(ks[3], (L, D_MODEL, 2 * D_FF), D_MODEL ** -0.5),
        "ffn1_w_down": nrm(ks[4], (L, D_FF, D_MODEL), D_FF ** -0.5),
        "mix_norm": gain(ks[5], (L, D_MODEL)),
        "w_in": nrm(ks[6], (L, D_MODEL, IN_WIDTH), D_MODEL ** -0.5),
        "q_norm": gain(ks[7], (L, HEAD_DIM)),
        "k_norm": gain(ks[8], (L, HEAD_DIM)),
        "rel_bias": nrm(ks[9], (N_BUCKETS, N_Q_HEADS), 0.5),
        "sinks": nrm(ks[10], (L, N_Q_HEADS), 1.0),
        "pool_w": nrm(ks[11], (L, N_POOL_GROUPS, POOL_GROUP_DIM, POOL_GROUP_DIM), POOL_GROUP_DIM ** -0.5),
        "pool_scale": gain(ks[12], (L, POOL_WIDTH)),
        "w_out": nrm(ks[13], (L, MIX_WIDTH, D_MODEL), MIX_WIDTH ** -0.5),
        "ffn2_norm": gain(ks[14], (L, D_MODEL)),
        "ffn2_w_gu": nrm(ks[15], (L, D_MODEL, 2 * D_FF), D_MODEL ** -0.5),
        "ffn2_w_down": nrm(ks[16], (L, D_FF, D_MODEL), D_FF ** -0.5),
        "ple_norm": gain(ks[17], (L, D_MODEL)),
        "ple_w_gate": nrm(ks[18], (L, D_MODEL, D_MODEL), D_MODEL ** -0.5),
        "ple_b_gate": nrm(ks[19], (L, D_MODEL), 0.02),
        "ple_w_proj": nrm(ks[20], (L, PLE_DIM, D_MODEL), PLE_DIM ** -0.5),
        "ple_post_norm": gain(ks[21], (L, D_MODEL)),
    }


def reference(x, p, ffn1_norm, ffn1_w_gu, ffn1_w_down, mix_norm, w_in, q_norm, k_norm,
              rel_bias, sinks, pool_w, pool_scale, w_out, ffn2_norm, ffn2_w_gu, ffn2_w_down,
              ple_norm, ple_w_gate, ple_b_gate, ple_w_proj, ple_post_norm):
    B, S, _ = x.shape
    for i in range(DEPTH):
        x = x + MACARON_WEIGHT * swiglu(rms_norm(x, ffn1_norm[i]), ffn1_w_gu[i], ffn1_w_down[i])
        h = rms_norm(x, mix_norm[i])
        proj = h @ w_in[i]
        q, k, v, u = jnp.split(
            proj, [ATTN_WIDTH, ATTN_WIDTH + KV_WIDTH, ATTN_WIDTH + 2 * KV_WIDTH], axis=-1)
        q = rms_norm(q.reshape(B, S, N_Q_HEADS, HEAD_DIM), q_norm[i])
        k = rms_norm(k.reshape(B, S, N_KV_HEADS, HEAD_DIM), k_norm[i])
        v = v.reshape(B, S, N_KV_HEADS, HEAD_DIM)
        a = sliding_window_attention(q, k, v, rel_bias, sinks[i])
        m = multiscale_pool(u, pool_w[i], pool_scale[i])
        x = x + jnp.concatenate([a, m], axis=-1) @ w_out[i]
        x = x + MACARON_WEIGHT * swiglu(rms_norm(x, ffn2_norm[i]), ffn2_w_gu[i], ffn2_w_down[i])
        gate = jax.nn.sigmoid(rms_norm(x, ple_norm[i]) @ ple_w_gate[i] + ple_b_gate[i])
        e = rms_norm(p[i] @ ple_w_proj[i], ple_post_norm[i])
        x = x + gate * e
    return x
```

```cpp
#include <hip/hip_runtime.h>
#include <hip/hip_cooperative_groups.h>
#include <cstdio>
#include <cstdint>
namespace cg = cooperative_groups;
#define MK_N_LAUNCHES 1
#define PG8_WGM 8
#define PH_REV 0
#define ATTN_SCHED_BAR 0
namespace pg8 {
#define PG8_LAS __attribute__((address_space(3)))
typedef unsigned short bf16_t;
typedef short bf16x8 __attribute__((ext_vector_type(8)));
typedef float f32x4 __attribute__((ext_vector_type(4)));
typedef unsigned u32x4 __attribute__((ext_vector_type(4)));
constexpr int BM = 256, BK = 64, HALF = 128, HTB = HALF * BK * 2  , STAGE_BYTES = 8 * HTB, NXCD = 8, WGM = PG8_WGM;

__host__ __device__ __forceinline__ int lds_byte(int r, int c) { const int st = (r >> 4) * 2 + (c >> 5), rr = r & 15, cc = c & 31, ob = rr * 64 + cc * 2; return st * 1024 + (ob ^ (((ob >> 9) & 1) << 5)); }
__host__ __device__ __forceinline__ void stage_rc(int b, int& R, int& C) { const int st = b / 1024, sb = b % 1024, swz = sb ^ (((sb >> 9) & 1) << 5); R = (st >> 1) * 16 + swz / 64; C = (st & 1) * 32 + (swz % 64) / 2; }
__host__ __device__ __forceinline__ int perm32(int rho) { const int n = rho >> 4, i = rho & 15; return 8 * (i >> 2) + 4 * n + (i & 3); }

struct Unit { int pm, pn; };
struct Gemm { const bf16_t* A; const bf16_t* Bt; int M, N, K; };

struct StaticOrder {
    int nM, nN, nwg, G, c, rev, hot = 0;
    __host__ __device__ void init(int M, int N, int G_, int c_, int rev_ = 0) { nM = M / BM; nN = N / BM; nwg = nM * nN; G = G_; c = c_; rev = (rev_ && (nwg % G_) == 0) ? 1 : 0; }
    __host__ __device__ bool next(int i, Unit& u) const {
        if (hot) { if (i >= hot) return false; u.pm = 0; u.pn = i % nN; return true; }
        int ii = i; if (rev) { const int nr = nwg / G; if (i >= nr) return false; ii = nr - 1 - i; }
        const long L = (long)ii * G + c; if (L >= nwg) return false;
        int wgid = (int)L; { const int q = nwg / NXCD, r = nwg % NXCD, xcd = wgid % NXCD, off = wgid / NXCD; wgid = (xcd < r ? xcd * (q + 1) : r * (q + 1) + (xcd - r) * q) + off; }
        const int nig = WGM * nN, gid = wgid / nig, fm = gid * WGM, gsz = (nM - fm) < WGM ? (nM - fm) : WGM;
        u.pm = fm + ((wgid % nig) % gsz); u.pn = (wgid % nig) / gsz; return true;
    }
    __device__ __forceinline__ void a_ready(const Unit&) const {}
    __device__ __forceinline__ void done(const Unit&) const {}
};

__device__ __forceinline__ unsigned cvt_pk_bf16(float lo, float hi) { unsigned r; asm volatile("v_cvt_pk_bf16_f32 %0, %1, %2" : "=v"(r) : "v"(lo), "v"(hi)); return r; }
typedef float f32x2 __attribute__((ext_vector_type(2)));
template <class Epi, class Sched, bool ALIGN_EPI = false, bool SP2 = false>
__device__ __forceinline__ void gemm_phase(PG8_LAS unsigned char* lds, const Gemm g, const Sched& S, const Epi& E) {
    const int tid = threadIdx.x, wid = __builtin_amdgcn_readfirstlane(tid >> 6), lane = tid & 63, wr = wid >> 2, wc = wid & 3, fr = lane & 15, fq = lane >> 4;
    const int K = g.K, nt = K / BK;
    unsigned voffA[2], voffB[2];
#pragma unroll
    for (int i = 0; i < 2; ++i) { int R, C; stage_rc(tid * 16 + i * 8192, R, C); const int Rb = Epi::PERM ? ((R & ~31) + perm32(R & 31)) : R;
        voffA[i] = (unsigned)(R * K + C) * 2u; voffB[i] = (unsigned)(Rb * K + C) * 2u; }
    const size_t kstep = (size_t)(BK * 2);
    const size_t hstep = (size_t)HALF * K * 2;
    const size_t tstep = 2 * hstep;
    const unsigned ldsw = (unsigned)wid * 1024u;
    const int aoff = lds_byte(wr * 64 + fr, fq * 8), boff = lds_byte(wc * 32 + fr, fq * 8);
#define PG8_SA(b, h) (((b) * 2 + (h)) * HTB)
#define PG8_SB(b, h) ((4 + (b) * 2 + (h)) * HTB)
#define PG8_STAGE(bufoff, gbase, voff) do { _Pragma("unroll") for (int _i = 0; _i < 2; ++_i) \
        __builtin_amdgcn_global_load_lds((const unsigned*)((const char*)(gbase) + (voff)[_i]), (PG8_LAS unsigned*)(lds + (bufoff) + ldsw + _i * 8192), 16, 0, 0); } while (0)
#define PG8_LDA(dst, b, h) do { _Pragma("unroll") for (int m = 0; m < 4; ++m) _Pragma("unroll") for (int k = 0; k < 2; ++k) dst[m][k] = *(const PG8_LAS bf16x8*)(lds + PG8_SA(b, h) + aoff + m * 2048 + k * 1024); } while (0)
#define PG8_LDB(dst, b, h) do { _Pragma("unroll") for (int n = 0; n < 2; ++n) _Pragma("unroll") for (int k = 0; k < 2; ++k) dst[n][k] = *(const PG8_LAS bf16x8*)(lds + PG8_SB(b, h) + boff + n * 2048 + k * 1024); } while (0)
#define PG8_MMA(ai, bj, At, Bt) do { __builtin_amdgcn_s_setprio(1); _Pragma("unroll") for (int m = 0; m < 4; ++m) _Pragma("unroll") for (int n = 0; n < 2; ++n) _Pragma("unroll") for (int k = 0; k < 2; ++k) \
        acc[ai][bj][m][n] = __builtin_amdgcn_mfma_f32_16x16x32_bf16(Bt[n][k], At[m][k], acc[ai][bj][m][n], 0, 0, 0); __builtin_amdgcn_s_setprio(0); } while (0)
#define PG8_WAIT_V(n) asm volatile("s_waitcnt vmcnt(" #n ")" ::: "memory")
#define PG8_WAIT_L(n) asm volatile("s_waitcnt lgkmcnt(" #n ")" ::: "memory")
#define PG8_BAR __builtin_amdgcn_s_barrier()
#define PG8_SCHED __builtin_amdgcn_sched_barrier(0)
    Unit cur, nxt; int ui = 0;
    if (!S.next(0, cur)) return;
    f32x4 acc[2][2][4][2];
#pragma unroll
    for (int a = 0; a < 2; ++a)
#pragma unroll
        for (int b = 0; b < 2; ++b)
#pragma unroll
            for (int m = 0; m < 4; ++m)
#pragma unroll
                for (int n = 0; n < 2; ++n) acc[a][b][m][n] = (f32x4){0.f, 0.f, 0.f, 0.f};
    bf16x8 At[4][2], B0[2][2], B1[2][2];
    const char* cA = (const char*)g.A + (size_t)cur.pm * tstep; const char* cB = (const char*)g.Bt + (size_t)cur.pn * tstep;
    S.a_ready(cur);
    if constexpr (SP2) {
        PG8_STAGE(PG8_SB(0, 0), cB, voffB); PG8_STAGE(PG8_SB(0, 1), cB + hstep, voffB); PG8_STAGE(PG8_SA(0, 0), cA, voffA); PG8_STAGE(PG8_SA(0, 1), cA + hstep, voffA);
        if (wr == 1) PG8_BAR;
        PG8_WAIT_V(2); PG8_BAR;
        PG8_STAGE(PG8_SB(1, 0), cB + kstep, voffB); PG8_STAGE(PG8_SA(1, 0), cA + kstep, voffA); PG8_STAGE(PG8_SB(1, 1), cB + hstep + kstep, voffB);
        PG8_WAIT_V(6); PG8_BAR;
    } else {
        PG8_STAGE(PG8_SB(0, 0), cB, voffB); PG8_STAGE(PG8_SA(0, 0), cA, voffA); PG8_STAGE(PG8_SB(0, 1), cB + hstep, voffB); PG8_STAGE(PG8_SA(0, 1), cA + hstep, voffA);
        if (wr == 1) PG8_BAR;
        PG8_WAIT_V(4); PG8_BAR;
        PG8_STAGE(PG8_SB(1, 0), cB + kstep, voffB); PG8_STAGE(PG8_SA(1, 0), cA + kstep, voffA); PG8_STAGE(PG8_SB(1, 1), cB + hstep + kstep, voffB);
        PG8_WAIT_V(6); PG8_BAR;
    }
    for (;;) {
        const bool has_next = S.next(ui + 1, nxt);
        const char* nA = has_next ? (const char*)g.A + (size_t)nxt.pm * tstep : cA; const char* nB = has_next ? (const char*)g.Bt + (size_t)nxt.pn * tstep : cB;
        for (int t = 0; t < nt; t += 2) {
            const bool last = (t == nt - 2);
            const char* a1 = cA + (size_t)(t + 1) * kstep;
            const char* a2 = last ? nA : cA + (size_t)(t + 2) * kstep; const char* b2 = last ? nB : cB + (size_t)(t + 2) * kstep;
            const char* a3 = a2 + kstep; const char* b3 = b2 + kstep;
            if (last && has_next) S.a_ready(nxt);
            if constexpr (SP2) {
            PG8_LDB(B0, 0, 0); PG8_LDB(B1, 0, 1); PG8_SCHED; PG8_LDA(At, 0, 0); PG8_STAGE(PG8_SA(1, 1), a1 + hstep, voffA);
            PG8_WAIT_V(8); PG8_WAIT_L(0); PG8_BAR; PG8_MMA(0, 0, At, B0); PG8_MMA(0, 1, At, B1); PG8_BAR; PG8_SCHED;
            PG8_LDA(At, 0, 1); PG8_STAGE(PG8_SB(0, 0), b2, voffB); PG8_STAGE(PG8_SB(0, 1), b2 + hstep, voffB); PG8_STAGE(PG8_SA(0, 0), a2, voffA);
            PG8_WAIT_V(8); PG8_WAIT_L(0); PG8_BAR; PG8_MMA(1, 0, At, B0); PG8_MMA(1, 1, At, B1); PG8_BAR; PG8_SCHED;
            PG8_LDB(B0, 1, 0); PG8_LDB(B1, 1, 1); PG8_SCHED; PG8_LDA(At, 1, 0); PG8_STAGE(PG8_SA(0, 1), a2 + hstep, voffA);
            PG8_WAIT_V(8); PG8_WAIT_L(0); PG8_BAR; PG8_MMA(0, 0, At, B0); PG8_MMA(0, 1, At, B1); PG8_BAR; PG8_SCHED;
            PG8_LDA(At, 1, 1); PG8_STAGE(PG8_SB(1, 0), b3, voffB); PG8_STAGE(PG8_SB(1, 1), b3 + hstep, voffB); PG8_STAGE(PG8_SA(1, 0), a3, voffA);
            PG8_WAIT_V(8); PG8_WAIT_L(0); PG8_BAR; PG8_MMA(1, 0, At, B0); PG8_MMA(1, 1, At, B1); PG8_BAR; PG8_SCHED;
            } else {
            PG8_LDB(B0, 0, 0); PG8_SCHED; PG8_LDA(At, 0, 0); PG8_STAGE(PG8_SA(1, 1), a1 + hstep, voffA);
            PG8_WAIT_L(8); PG8_BAR; PG8_WAIT_L(0); PG8_MMA(0, 0, At, B0); PG8_BAR; PG8_SCHED;
            PG8_LDB(B1, 0, 1); PG8_STAGE(PG8_SB(0, 0), b2, voffB);
            PG8_BAR; PG8_WAIT_L(0); PG8_MMA(0, 1, At, B1); PG8_BAR;
            PG8_LDA(At, 0, 1); PG8_STAGE(PG8_SA(0, 0), a2, voffA);
            PG8_BAR; PG8_WAIT_L(0); PG8_MMA(1, 0, At, B0); PG8_BAR; PG8_SCHED;
            PG8_STAGE(PG8_SB(0, 1), b2 + hstep, voffB);
            PG8_WAIT_V(6); PG8_BAR; PG8_MMA(1, 1, At, B1); PG8_BAR;
            PG8_LDB(B0, 1, 0); PG8_SCHED; PG8_LDA(At, 1, 0); PG8_STAGE(PG8_SA(0, 1), a2 + hstep, voffA);
            PG8_WAIT_L(8); PG8_BAR; PG8_WAIT_L(0); PG8_MMA(0, 0, At, B0); PG8_BAR; PG8_SCHED;
            PG8_LDB(B1, 1, 1); PG8_STAGE(PG8_SB(1, 0), b3, voffB);
            PG8_BAR; PG8_WAIT_L(0); PG8_MMA(0, 1, At, B1); PG8_BAR;
            PG8_LDA(At, 1, 1); PG8_STAGE(PG8_SA(1, 0), a3, voffA);
            PG8_BAR; PG8_WAIT_L(0); PG8_MMA(1, 0, At, B0); PG8_BAR; PG8_SCHED;
            PG8_STAGE(PG8_SB(1, 1), b3 + hstep, voffB);
            PG8_WAIT_V(6); PG8_BAR; PG8_MMA(1, 1, At, B1); PG8_BAR;
            }
        }
        if constexpr (ALIGN_EPI) { if (wr == 0) PG8_BAR; }
        if constexpr (!Epi::AFTER_DRAIN) { E(acc, cur, wr, wc, fr, fq); S.done(cur); }
        if (!has_next) break;
#pragma unroll
        for (int a = 0; a < 2; ++a)
#pragma unroll
            for (int b = 0; b < 2; ++b)
#pragma unroll
                for (int m = 0; m < 4; ++m)
#pragma unroll
                    for (int n = 0; n < 2; ++n) acc[a][b][m][n] = (f32x4){0.f, 0.f, 0.f, 0.f};
        cur = nxt; cA = nA; cB = nB; ++ui;
        if constexpr (ALIGN_EPI) { if (wr == 1) PG8_BAR; }
    }
    PG8_WAIT_V(0);
    if constexpr (!ALIGN_EPI) { if (wr == 0) PG8_BAR; }
    PG8_BAR;
    if constexpr (Epi::AFTER_DRAIN) { E.fused(acc, cur, wr, wc, fr, fq, lds, wid, lane); S.done(cur); }
#undef PG8_SA
#undef PG8_SB
#undef PG8_STAGE
#undef PG8_LDA
#undef PG8_LDB
#undef PG8_MMA
#undef PG8_WAIT_V
#undef PG8_WAIT_L
#undef PG8_BAR
#undef PG8_SCHED
}
}

#ifndef MK_N_LAUNCHES
#define MK_N_LAUNCHES 1
#endif
#ifndef ATTN_SCHED_BAR
#define ATTN_SCHED_BAR 1
#endif
#ifndef PH_REV
#define PH_REV 1
#endif
#ifndef GEMM_ALIGN
#define GEMM_ALIGN true
#endif
#ifndef GEMM_SP2
#define GEMM_SP2 true
#endif
constexpr int BATCH = 32, SEQ = 2048, M = BATCH * SEQ, D = 1024, FF = 2816, NGU = 2 * FF, NIN = 1280, PLE = 256;
constexpr float EPS = 1e-6f, LOG2E = 1.4426950408889634f;
constexpr int NPHASE = 9;

#define LAS __attribute__((address_space(3)))
using pg8::bf16_t; using pg8::bf16x8; using pg8::f32x4; using pg8::u32x4; using pg8::Unit; using pg8::cvt_pk_bf16;
typedef short s16x4 __attribute__((ext_vector_type(4)));
typedef unsigned u32x2 __attribute__((ext_vector_type(2)));

constexpr size_t MiB = 1u << 20;
constexpr size_t WS_SSQ = 0;
constexpr size_t WS_BAR = 1536 * 1024;
constexpr size_t WS_WGU1 = 2 * MiB, WS_WD1 = 13 * MiB, WS_WIN = 19 * MiB, WS_WOUT = 22 * MiB, WS_WGU2 = 24 * MiB, WS_WD2 = 35 * MiB, WS_WG = 41 * MiB, WS_WP = 43 * MiB;
constexpr size_t WS_XB = 64 * MiB;
constexpr size_t WS_H = 192 * MiB;
constexpr size_t WS_Q = 544 * MiB, WS_K = 608 * MiB, WS_V = 624 * MiB, WS_Z = 640 * MiB, WS_MIX = 704 * MiB, WS_PP = 832 * MiB, WS_PB = 960 * MiB, WS_END = 992 * MiB;

constexpr int LDS_BYTES = 147456;
constexpr int LDS_MISC_OFF = 131072 + 64;
constexpr int KS_STRIDE = 72, VT_STRIDE = 264;
constexpr int ATT_K_OFF = 0, ATT_V_OFF = 256 * KS_STRIDE * 2, ATT_B_OFF = ATT_V_OFF + 64 * VT_STRIDE * 2;

__device__ __forceinline__ unsigned f2bf(float f) { unsigned u = __builtin_bit_cast(unsigned, f); return (u + 0x7fffu + ((u >> 16) & 1u)) >> 16; }
__device__ __forceinline__ unsigned pk2(float lo, float hi) { return f2bf(lo) | (f2bf(hi) << 16); }
__device__ __forceinline__ float bflo(unsigned w) { return __uint_as_float(w << 16); }
__device__ __forceinline__ float bfhi(unsigned w) { return __uint_as_float(w & 0xffff0000u); }
__device__ __forceinline__ float rs_of(float ssq, float invn) { return __builtin_amdgcn_rsqf(ssq * invn + EPS); }
__device__ __forceinline__ float sigmoid_f(float a) { return __builtin_amdgcn_rcpf(1.0f + __builtin_amdgcn_exp2f(-a * LOG2E)); }
__device__ __forceinline__ float dot4(f32x4 v) { return (v[0] * v[0] + v[1] * v[1]) + (v[2] * v[2] + v[3] * v[3]); }
__device__ __forceinline__ float quad_sum(float s) { s += __shfl_xor(s, 16); s += __shfl_xor(s, 32); return s; }
__device__ __forceinline__ float wave_sum(float v) {
#pragma unroll
    for (int o = 1; o < 64; o <<= 1) v += __shfl_xor(v, o);
    return v;
}
__device__ __forceinline__ u32x4 pack8(f32x4 a, f32x4 b) { u32x4 w; w.x = cvt_pk_bf16(a[0], a[1]); w.y = cvt_pk_bf16(a[2], a[3]); w.z = cvt_pk_bf16(b[0], b[1]); w.w = cvt_pk_bf16(b[2], b[3]); return w; }

struct EpiGU {
    static constexpr bool PERM = true, AFTER_DRAIN = false;
    bf16_t* H; const float* ssq; int nostore = 0;
    __device__ __forceinline__ void operator()(const f32x4 (&acc)[2][2][4][2], const Unit& u, int wr, int wc, int fr, int fq) const {
        typedef float f32x2 __attribute__((ext_vector_type(2)));
        const int row0 = u.pm * 256 + wr * 64 + fr, col0 = u.pn * 128 + wc * 32 + 8 * fq;
        float rsv[2][4];
#pragma unroll
        for (int ai = 0; ai < 2; ++ai)
#pragma unroll
            for (int m = 0; m < 4; ++m) rsv[ai][m] = ssq[row0 + ai * 128 + m * 16];
        asm volatile("" ::: "memory");
#pragma unroll
        for (int ai = 0; ai < 2; ++ai)
#pragma unroll
            for (int m = 0; m < 4; ++m) {
                const int row = row0 + ai * 128 + m * 16;
                const float rs = rs_of(rsv[ai][m], 1.0f / D);
                const float nrs = -rs * LOG2E, rs2 = rs * rs;
                f32x4 h[2];
#pragma unroll
                for (int n = 0; n < 2; ++n)
#pragma unroll
                    for (int hh = 0; hh < 2; ++hh) {
                        const f32x2 g = (f32x2){acc[ai][0][m][n][2 * hh], acc[ai][0][m][n][2 * hh + 1]}, uu = (f32x2){acc[ai][1][m][n][2 * hh], acc[ai][1][m][n][2 * hh + 1]};
                        const f32x2 t = g * nrs; f32x2 e; e.x = __builtin_amdgcn_exp2f(t.x); e.y = __builtin_amdgcn_exp2f(t.y);
                        const f32x2 d = e + 1.0f; f32x2 r; r.x = __builtin_amdgcn_rcpf(d.x); r.y = __builtin_amdgcn_rcpf(d.y);
                        const f32x2 o = (g * uu) * (r * rs2);
                        h[n][2 * hh] = o.x; h[n][2 * hh + 1] = o.y;
                    }
                const u32x4 hw = pack8(h[0], h[1]);
                if (!nostore) *(u32x4*)(H + (size_t)row * FF + col0) = hw;
                else asm volatile("" :: "v"(hw));
            }
    }
};
template <bool BASE_F32> struct EpiRes {
    static constexpr bool PERM = true, AFTER_DRAIN = false;
    const float* basef; const bf16_t* baseb; bf16_t* xb; float* ssq; float alpha;
    __device__ __forceinline__ void operator()(const f32x4 (&acc)[2][2][4][2], const Unit& u, int wr, int wc, int fr, int fq) const {
        const int row0 = u.pm * 256 + wr * 64 + fr, col0 = u.pn * 256 + wc * 32 + 8 * fq;
#pragma unroll
        for (int ai = 0; ai < 2; ++ai) {
            f32x4 b[4][2][2];
#pragma unroll
            for (int m = 0; m < 4; ++m)
#pragma unroll
                for (int bj = 0; bj < 2; ++bj) {
                    const size_t off = (size_t)(row0 + ai * 128 + m * 16) * D + col0 + bj * 128;
                    if constexpr (BASE_F32) { b[m][bj][0] = *(const f32x4*)(basef + off); b[m][bj][1] = *(const f32x4*)(basef + off + 4); }
                    else { const u32x4 w = *(const u32x4*)(baseb + off); b[m][bj][0] = __builtin_bit_cast(f32x4, w); }
                }
            asm volatile("" ::: "memory");
#pragma unroll
            for (int m = 0; m < 4; ++m) {
                const int row = row0 + ai * 128 + m * 16; float s = 0.f;
#pragma unroll
                for (int bj = 0; bj < 2; ++bj) {
                    const size_t off = (size_t)row * D + col0 + bj * 128;
                    f32x4 b0, b1;
                    if constexpr (BASE_F32) { b0 = b[m][bj][0]; b1 = b[m][bj][1]; }
                    else { const u32x4 w = __builtin_bit_cast(u32x4, b[m][bj][0]); b0 = (f32x4){bflo(w.x), bfhi(w.x), bflo(w.y), bfhi(w.y)}; b1 = (f32x4){bflo(w.z), bfhi(w.z), bflo(w.w), bfhi(w.w)}; }
                    const f32x4 v0 = b0 + acc[ai][bj][m][0] * alpha, v1 = b1 + acc[ai][bj][m][1] * alpha;
                    *(u32x4*)(xb + off) = pack8(v0, v1);
                    s += dot4(v0) + dot4(v1);
                }
                s = quad_sum(s);
                if (fq == 0) unsafeAtomicAdd(ssq + row, s);
            }
            asm volatile("" ::: "memory");
        }
    }
};
struct EpiWin {
    static constexpr bool PERM = true, AFTER_DRAIN = false;
    bf16_t *Q, *K, *V, *Z; const float* ssq; const float* qg; const float* kg;
    __device__ __forceinline__ void operator()(const f32x4 (&acc)[2][2][4][2], const Unit& u, int wr, int wc, int fr, int fq) const {
        const int row0 = u.pm * 256 + wr * 64 + fr, pn = u.pn;
        const bool normed = (pn < 2) || (pn == 2 && wc < 2);
        f32x4 ggn[2][2];
        { const float* gn = (pn < 2) ? qg : kg;
#pragma unroll
          for (int bj = 0; bj < 2; ++bj)
#pragma unroll
              for (int n = 0; n < 2; ++n) ggn[bj][n] = normed ? *(const f32x4*)(gn + bj * 32 + 8 * fq + 4 * n) : (f32x4){1.f, 1.f, 1.f, 1.f}; }
        float rsv[2][4];
#pragma unroll
        for (int ai = 0; ai < 2; ++ai)
#pragma unroll
            for (int m = 0; m < 4; ++m) rsv[ai][m] = ssq[row0 + ai * 128 + m * 16];
        asm volatile("" ::: "memory");
#pragma unroll
        for (int ai = 0; ai < 2; ++ai)
#pragma unroll
            for (int m = 0; m < 4; ++m) {
                const int row = row0 + ai * 128 + m * 16;
                const float rs = rs_of(rsv[ai][m], 1.0f / D);
                f32x4 v[2][2];
#pragma unroll
                for (int bj = 0; bj < 2; ++bj)
#pragma unroll
                    for (int n = 0; n < 2; ++n) v[bj][n] = acc[ai][bj][m][n] * rs;
                if (normed) {
                    float s = (dot4(v[0][0]) + dot4(v[0][1])) + (dot4(v[1][0]) + dot4(v[1][1]));
                    s = quad_sum(s);
                    const float rq = rs_of(s, 1.0f / 64.0f);
                    const float sc = (pn < 2) ? rq * (0.125f * LOG2E) : rq;
#pragma unroll
                    for (int bj = 0; bj < 2; ++bj)
#pragma unroll
                        for (int n = 0; n < 2; ++n) v[bj][n] = v[bj][n] * ggn[bj][n] * sc;
                }
                bf16_t* p;
                if (pn < 2) p = Q + (size_t)row * 512 + (pn * 4 + wc) * 64;
                else if (pn == 2) p = (wc < 2) ? K + (size_t)row * 128 + wc * 64 : V + (size_t)row * 128 + (wc - 2) * 64;
                else p = Z + (size_t)row * 512 + (pn - 3) * 256 + wc * 64;
#pragma unroll
                for (int bj = 0; bj < 2; ++bj) *(u32x4*)(p + bj * 32 + 8 * fq) = pack8(v[bj][0], v[bj][1]);
            }
    }
};
struct EpiPP {
    static constexpr bool PERM = true, AFTER_DRAIN = false;
    bf16_t* PP; float* ssq; const float* pg;
    __device__ __forceinline__ void operator()(const f32x4 (&acc)[2][2][4][2], const Unit& u, int wr, int wc, int fr, int fq) const {
        const int row0 = u.pm * 256 + wr * 64 + fr, col0 = u.pn * 256 + wc * 32 + 8 * fq;
        f32x4 gg[2][2];
#pragma unroll
        for (int bj = 0; bj < 2; ++bj)
#pragma unroll
            for (int n = 0; n < 2; ++n) gg[bj][n] = *(const f32x4*)(pg + col0 + bj * 128 + 4 * n);
        asm volatile("" ::: "memory");
#pragma unroll
        for (int ai = 0; ai < 2; ++ai)
#pragma unroll
            for (int m = 0; m < 4; ++m) {
                const int row = row0 + ai * 128 + m * 16; float s = 0.f;
#pragma unroll
                for (int bj = 0; bj < 2; ++bj) {
                    const size_t off = (size_t)row * D + col0 + bj * 128;
                    *(u32x4*)(PP + off) = pack8(acc[ai][bj][m][0] * gg[bj][0], acc[ai][bj][m][1] * gg[bj][1]);
                    s += dot4(acc[ai][bj][m][0]) + dot4(acc[ai][bj][m][1]);
                }
                s = quad_sum(s);
                if (fq == 0) unsafeAtomicAdd(ssq + row, s);
            }
    }
};
struct EpiGate {
    static constexpr bool PERM = true, AFTER_DRAIN = false;
    float* OUT; const bf16_t* XBs; const bf16_t* PP; const float *ssq3, *ssqE, *bg;
    __device__ __forceinline__ void operator()(const f32x4 (&acc)[2][2][4][2], const Unit& u, int wr, int wc, int fr, int fq) const {
        typedef float f32x2 __attribute__((ext_vector_type(2)));
        const int row0 = u.pm * 256 + wr * 64 + fr, col0 = u.pn * 256 + wc * 32 + 8 * fq;
        f32x4 bb[2][2];
#pragma unroll
        for (int bj = 0; bj < 2; ++bj)
#pragma unroll
            for (int n = 0; n < 2; ++n) bb[bj][n] = *(const f32x4*)(bg + col0 + bj * 128 + 4 * n);
#pragma unroll
        for (int ai = 0; ai < 2; ++ai)
#pragma unroll
            for (int mp = 0; mp < 2; ++mp) {
                u32x4 xw[2][2], pw[2][2]; float s3[2], sE[2];
#pragma unroll
                for (int mm = 0; mm < 2; ++mm) {
                    const int row = row0 + ai * 128 + (2 * mp + mm) * 16; s3[mm] = ssq3[row]; sE[mm] = ssqE[row];
#pragma unroll
                    for (int bj = 0; bj < 2; ++bj) {
                        const size_t off = (size_t)row * D + col0 + bj * 128;
                        xw[mm][bj] = *(const u32x4*)(XBs + off); pw[mm][bj] = *(const u32x4*)(PP + off);
                    }
                }
                asm volatile("" ::: "memory");
#pragma unroll
                for (int mm = 0; mm < 2; ++mm) {
                    const int m = 2 * mp + mm; const float r3 = rs_of(s3[mm], 1.0f / D), rE = rs_of(sE[mm], 1.0f / D), nr3 = -r3 * LOG2E;
#pragma unroll
                    for (int bj = 0; bj < 2; ++bj) {
                        const size_t off = (size_t)(row0 + ai * 128 + m * 16) * D + col0 + bj * 128;
                        const unsigned pws[4] = {pw[mm][bj].x, pw[mm][bj].y, pw[mm][bj].z, pw[mm][bj].w}, xws[4] = {xw[mm][bj].x, xw[mm][bj].y, xw[mm][bj].z, xw[mm][bj].w};
                        f32x4 o[2];
#pragma unroll
                        for (int h = 0; h < 4; ++h) {
                            const int n = h >> 1, i0 = 2 * (h & 1);
                            const f32x2 ac = (f32x2){acc[ai][bj][m][n][i0], acc[ai][bj][m][n][i0 + 1]}, bv = (f32x2){bb[bj][n][i0], bb[bj][n][i0 + 1]};
                            const f32x2 t = ac * nr3 - bv * LOG2E; f32x2 ex; ex.x = __builtin_amdgcn_exp2f(t.x); ex.y = __builtin_amdgcn_exp2f(t.y);
                            const f32x2 dd = ex + 1.0f; f32x2 r; r.x = __builtin_amdgcn_rcpf(dd.x); r.y = __builtin_amdgcn_rcpf(dd.y);
                            const f32x2 ev = (f32x2){bflo(pws[h]), bfhi(pws[h])}, xv = (f32x2){bflo(xws[h]), bfhi(xws[h])};
                            const f32x2 ov = xv + r * (ev * rE);
                            o[n][i0] = ov.x; o[n][i0 + 1] = ov.y;
                        }
                        *(f32x4*)(OUT + off) = o[0]; *(f32x4*)(OUT + off + 4) = o[1];
                    }
                }
                asm volatile("" ::: "memory");
            }
    }
};

__device__ __forceinline__ void transpose_item(const float* W, int ldw, int K, const float* gain, bf16_t* WT, int k0, int c0, int j0, LAS float* scr, int lane) {
    float v[32];
#pragma unroll
    for (int i = 0; i < 32; ++i) { const int kk = 2 * i + (lane >> 5); v[i] = W[(size_t)(k0 + kk) * ldw + c0 + (lane & 31)]; }
#pragma unroll
    for (int i = 0; i < 32; ++i) { const int kk = 2 * i + (lane >> 5); scr[kk * 33 + (lane & 31)] = v[i]; }
    asm volatile("s_waitcnt lgkmcnt(0)" ::: "memory");
    const int c = lane & 7;
    f32x4 g0 = (f32x4){1.f, 1.f, 1.f, 1.f}, g1 = g0;
    if (gain) { g0 = *(const f32x4*)(gain + k0 + 8 * c); g1 = *(const f32x4*)(gain + k0 + 8 * c + 4); }
#pragma unroll
    for (int j = 0; j < 4; ++j) { const int n = (lane >> 3) + 8 * j; const LAS float* s = scr + (8 * c) * 33 + n;
        u32x4 o; o.x = pk2(s[0 * 33] * g0[0], s[1 * 33] * g0[1]); o.y = pk2(s[2 * 33] * g0[2], s[3 * 33] * g0[3]); o.z = pk2(s[4 * 33] * g1[0], s[5 * 33] * g1[1]); o.w = pk2(s[6 * 33] * g1[2], s[7 * 33] * g1[3]);
        *(u32x4*)(WT + (size_t)(j0 + n) * K + k0 + 8 * c) = o; }
    asm volatile("s_waitcnt lgkmcnt(0)" ::: "memory");
}
__device__ __forceinline__ int cmap_gu(int j0) { const int pn = j0 >> 8, r = j0 & 255; return ((r >> 7) ? FF : 0) + 128 * pn + (r & 127); }
__device__ __forceinline__ int cmap_win(int j0) { const int pn = j0 >> 8, r = j0 & 255; return 256 * pn + 64 * ((r & 127) >> 5) + 32 * (r >> 7); }

struct Args {
    const float* in[22]; float* out; unsigned char* ws; int ph_lo, ph_hi;
};
__device__ __forceinline__ const float* inp(const Args& a, int k) { asm volatile("" : "+s"(k)); return a.in[k]; }

__device__ __forceinline__ void prologue(const Args& a, LAS unsigned char* lds, int tid, int wave, int lane, int G) {
    unsigned char* ws = a.ws;
    LAS float* scr = (LAS float*)(lds + (wave & 3) * 16384);
    const bool xform = wave < 4;
    const int gw = blockIdx.x * 4 + (wave & 3), NGW = G * 4;
    if (xform) {
    constexpr int I_GU = (D / 64) * (NGU / 32), I_DN = (FF / 64) * (D / 32), I_WIN = (D / 64) * (768 / 32), I_SQ = (D / 64) * (D / 32), I_PR = (PLE / 64) * (D / 32);
    constexpr int NITEMS = 2 * I_GU + 2 * I_DN + I_WIN + 2 * I_SQ + I_PR;
    for (int it = gw; it < NITEMS; it += NGW) {
        int r = it;
        if (r < I_GU) { const int nb = NGU / 32, kb = r / nb, jb = r % nb; transpose_item(inp(a, 3), NGU, D, inp(a, 2), (bf16_t*)(ws + WS_WGU1), 64 * kb, cmap_gu(32 * jb), 32 * jb, scr, lane); continue; } r -= I_GU;
        if (r < I_GU) { const int nb = NGU / 32, kb = r / nb, jb = r % nb; transpose_item(inp(a, 15), NGU, D, inp(a, 14), (bf16_t*)(ws + WS_WGU2), 64 * kb, cmap_gu(32 * jb), 32 * jb, scr, lane); continue; } r -= I_GU;
        if (r < I_DN) { const int nb = D / 32, kb = r / nb, jb = r % nb; transpose_item(inp(a, 4), D, FF, nullptr, (bf16_t*)(ws + WS_WD1), 64 * kb, 32 * jb, 32 * jb, scr, lane); continue; } r -= I_DN;
        if (r < I_DN) { const int nb = D / 32, kb = r / nb, jb = r % nb; transpose_item(inp(a, 16), D, FF, nullptr, (bf16_t*)(ws + WS_WD2), 64 * kb, 32 * jb, 32 * jb, scr, lane); continue; } r -= I_DN;
        if (r < I_WIN) { const int nb = 768 / 32, kb = r / nb, jb = r % nb; transpose_item(inp(a, 6), NIN, D, inp(a, 5), (bf16_t*)(ws + WS_WIN), 64 * kb, cmap_win(32 * jb), 32 * jb, scr, lane); continue; } r -= I_WIN;
        if (r < I_SQ) { const int nb = D / 32, kb = r / nb, jb = r % nb; transpose_item(inp(a, 13), D, D, nullptr, (bf16_t*)(ws + WS_WOUT), 64 * kb, 32 * jb, 32 * jb, scr, lane); continue; } r -= I_SQ;
        if (r < I_SQ) { const int nb = D / 32, kb = r / nb, jb = r % nb; transpose_item(inp(a, 18), D, D, inp(a, 17), (bf16_t*)(ws + WS_WG), 64 * kb, 32 * jb, 32 * jb, scr, lane); continue; } r -= I_SQ;
        { const int nb = D / 32, kb = r / nb, jb = r % nb; transpose_item(inp(a, 20), D, PLE, nullptr, (bf16_t*)(ws + WS_WP), 64 * kb, 32 * jb, 32 * jb, scr, lane); }
    }
    {
        const float* w_in = inp(a, 6); const float* pool_w = inp(a, 11); const float* pscale = inp(a, 12); const float* mg = inp(a, 5);
        bf16_t* WT = (bf16_t*)(ws + WS_WIN);
        for (int it = gw; it < 4 * 128; it += NGW) {
            const int g = it >> 7, k0 = (it & 127) * 8;
            const float* pw = pool_w + g * 16384 + 2 * lane; const float* wr = w_in + (size_t)k0 * NIN + 768 + 128 * g;
            typedef float f32x2 __attribute__((ext_vector_type(2)));
            float acc[8][2];
#pragma unroll
            for (int r = 0; r < 8; ++r) { acc[r][0] = 0.f; acc[r][1] = 0.f; }
#pragma unroll 2
            for (int c = 0; c < 128; c += 4) {
                f32x2 p[4];
#pragma unroll
                for (int cc = 0; cc < 4; ++cc) p[cc] = *(const f32x2*)(pw + (c + cc) * 128);
#pragma unroll
                for (int r = 0; r < 8; ++r) {
                    const f32x4 wv = *(const f32x4*)(wr + (size_t)r * NIN + c);
#pragma unroll
                    for (int cc = 0; cc < 4; ++cc) { acc[r][0] += wv[cc] * p[cc].x; acc[r][1] += wv[cc] * p[cc].y; }
                }
            }
            const f32x4 m0 = *(const f32x4*)(mg + k0), m1 = *(const f32x4*)(mg + k0 + 4);
#pragma unroll
            for (int e = 0; e < 2; ++e) {
                const int zc = g * 128 + 2 * lane + e; const int j = 256 * (3 + (zc >> 8)) + 128 * ((zc & 63) >> 5) + 32 * ((zc & 255) >> 6) + (zc & 31);
                const float sc = pscale[zc];
                u32x4 o; o.x = pk2(acc[0][e] * m0[0] * sc, acc[1][e] * m0[1] * sc); o.y = pk2(acc[2][e] * m0[2] * sc, acc[3][e] * m0[3] * sc);
                o.z = pk2(acc[4][e] * m1[0] * sc, acc[5][e] * m1[1] * sc); o.w = pk2(acc[6][e] * m1[2] * sc, acc[7][e] * m1[3] * sc);
                *(u32x4*)(WT + (size_t)j * D + k0) = o;
            }
        }
    }
    } else {
    {
        const float* x = inp(a, 0); bf16_t* XB = (bf16_t*)(ws + WS_XB); float* ssq0 = (float*)(ws + WS_SSQ);
        for (int m = gw; m < M; m += 4 * NGW) {
            f32x4 v[4][4]; float sq[4];
#pragma unroll
            for (int r = 0; r < 4; ++r) { const int mr = m + r * NGW; const f32x4* xr = (const f32x4*)(x + (size_t)(mr < M ? mr : m) * D) + lane;
#pragma unroll
                for (int j = 0; j < 4; ++j) v[r][j] = xr[64 * j]; }
#pragma unroll
            for (int r = 0; r < 4; ++r) { float s = 0.f;
#pragma unroll
                for (int j = 0; j < 4; ++j) s += dot4(v[r][j]);
                sq[r] = wave_sum(s); }
#pragma unroll
            for (int r = 0; r < 4; ++r) { const int mr = m + r * NGW;
                if (mr < M) { u32x2* o8 = (u32x2*)(XB + (size_t)mr * D) + lane;
#pragma unroll
                    for (int j = 0; j < 4; ++j) { u32x2 w; w.x = cvt_pk_bf16(v[r][j][0], v[r][j][1]); w.y = cvt_pk_bf16(v[r][j][2], v[r][j][3]); o8[64 * j] = w; }
                    if (lane == 0) ssq0[mr] = sq[r]; } }
        }
    }
    {
        const float* p = inp(a, 1); bf16_t* PB = (bf16_t*)(ws + WS_PB);
        for (int m = gw; m < M; m += 8 * NGW) {
            f32x4 v[8];
#pragma unroll
            for (int r = 0; r < 8; ++r) { const int mr = m + r * NGW; v[r] = *((const f32x4*)(p + (size_t)(mr < M ? mr : m) * PLE) + lane); }
#pragma unroll
            for (int r = 0; r < 8; ++r) { const int mr = m + r * NGW; if (mr < M) { u32x2 w; w.x = cvt_pk_bf16(v[r][0], v[r][1]); w.y = cvt_pk_bf16(v[r][2], v[r][3]); *((u32x2*)(PB + (size_t)mr * PLE) + lane) = w; } }
        }
    }
    }
    {
        float* z = (float*)(ws + WS_SSQ) + M;
        for (int i = blockIdx.x * 512 + tid; i < 4 * M; i += G * 512) z[i] = 0.f;
    }
}

struct AttnRegs { u32x4 k[4], v[4]; };
__device__ __forceinline__ void attn_load(AttnRegs& R, const bf16_t* Q, const bf16_t* Kg, const bf16_t* Vg, int unit, int tid, int wave, int lane) {
    const int b = unit >> 5, kvh = (unit >> 4) & 1, nb = unit & 15;
    const size_t rowq0 = (size_t)b * SEQ + (size_t)nb * 128;
    const long rowk0 = (long)b * SEQ + (long)(nb - 1) * 128;
#pragma unroll
    for (int it = 0; it < 4; ++it) {
        const int idx = tid + 512 * it, key = idx & 255, ch = idx >> 8;
        R.k[it] = (u32x4){0u, 0u, 0u, 0u}; R.v[it] = (u32x4){0u, 0u, 0u, 0u};
        if (nb > 0 || key >= 128) { const size_t g = (size_t)(rowk0 + key) * 128 + kvh * 64 + ch * 8; R.k[it] = *(const u32x4*)(Kg + g); R.v[it] = *(const u32x4*)(Vg + g); }
    }
}
__device__ __forceinline__ void attn_phase(LAS unsigned char* lds, const bf16_t* Q, const bf16_t* Kg, const bf16_t* Vg, const float* rel_bias, const float* sinks, bf16_t* MIX,
                                           int tid, int wave, int lane, int G) {
    LAS bf16_t* Ks = (LAS bf16_t*)(lds + ATT_K_OFF); LAS bf16_t* Vt = (LAS bf16_t*)(lds + ATT_V_OFF); LAS float* Bt = (LAS float*)(lds + ATT_B_OFF);
    constexpr int NUNIT = BATCH * 32;
    const bool grp_ = (G == 256);
    int unit = grp_ ? 128 * ((int)blockIdx.x & 7) + ((int)blockIdx.x >> 3) : (int)blockIdx.x;
    const int ustep = grp_ ? 32 : G;
    const int nun = grp_ ? 4 : (unit < NUNIT ? (NUNIT - 1 - unit) / G + 1 : 0);
    if (nun <= 0) return;
    AttnRegs R; attn_load(R, Q, Kg, Vg, unit, tid, wave, lane);
    bf16x8 qf[4][2];
#define ATTN_LOAD_Q(un) do { const int b_ = (un) >> 5, kvh_ = ((un) >> 4) & 1, nb_ = (un) & 15; const size_t rq_ = (size_t)b_ * SEQ + (size_t)nb_ * 128; const int head_ = kvh_ * 4 + (wave >> 1); \
        _Pragma("unroll") for (int rt = 0; rt < 4; ++rt) { const bf16_t* qp = Q + (rq_ + (wave & 1) * 64 + rt * 16 + (lane & 15)) * 512 + head_ * 64 + 8 * (lane >> 4); \
            qf[rt][0] = *(const bf16x8*)qp; qf[rt][1] = *(const bf16x8*)(qp + 32); } } while (0)
    ATTN_LOAD_Q(unit);
    int kvh_cur = -1; float sinkl = 0.f; float bm[9][4];
#pragma unroll
    for (int tt = 0; tt < 9; ++tt)
#pragma unroll
        for (int i = 0; i < 4; ++i) bm[tt][i] = 0.f;
    for (int it_ = 0; it_ < nun; ++it_, unit += ustep) {
        const int b = unit >> 5, kvh = (unit >> 4) & 1, nb = unit & 15;
        const size_t rowq0 = (size_t)b * SEQ + (size_t)nb * 128;
        const bool newtab = (kvh != kvh_cur);
#pragma unroll
        for (int it = 0; it < 4; ++it) {
            const int idx = tid + 512 * it, key = idx & 255, ch = idx >> 8;
            *(LAS u32x4*)(Ks + key * KS_STRIDE + ch * 8) = R.k[it];
            LAS bf16_t* vp = Vt + (ch * 8) * VT_STRIDE + key; const u32x4 vv = R.v[it];
            vp[0 * VT_STRIDE] = (bf16_t)(vv.x & 0xffffu); vp[1 * VT_STRIDE] = (bf16_t)(vv.x >> 16);
            vp[2 * VT_STRIDE] = (bf16_t)(vv.y & 0xffffu); vp[3 * VT_STRIDE] = (bf16_t)(vv.y >> 16);
            vp[4 * VT_STRIDE] = (bf16_t)(vv.z & 0xffffu); vp[5 * VT_STRIDE] = (bf16_t)(vv.z >> 16);
            vp[6 * VT_STRIDE] = (bf16_t)(vv.w & 0xffffu); vp[7 * VT_STRIDE] = (bf16_t)(vv.w >> 16);
        }
        if (newtab) {
            const int g = tid >> 7, dist = tid & 127;
            int bucket = dist;
            if (dist >= 16) { int lg = 16 + (int)(logf((float)dist / 16.0f) / logf(8.0f) * 16.0f); bucket = lg < 31 ? lg : 31; }
            Bt[tid] = rel_bias[bucket * 8 + kvh * 4 + g] * LOG2E;
        }
        __syncthreads();
        if (it_ + 1 < nun) attn_load(R, Q, Kg, Vg, unit + ustep, tid, wave, lane);
        const int g = wave >> 1, head = kvh * 4 + g, fr = lane & 15, fq = lane >> 4;
        if (newtab) {
            kvh_cur = kvh; sinkl = sinks[head] * LOG2E;
#pragma unroll
            for (int tt = 0; tt < 9; ++tt)
#pragma unroll
                for (int i = 0; i < 4; ++i) { const int dist = fr + 128 - 16 * tt - 4 * fq - i; bm[tt][i] = (dist >= 0 && dist < 128) ? Bt[g * 128 + (dist & 127)] : -1e30f; }
        }
#pragma unroll
        for (int rt = 0; rt < 4; ++rt) {
            const int q0 = (wave & 1) * 64 + rt * 16, jt0 = q0 >> 4;
            f32x4 S[9];
#pragma unroll
            for (int tt = 0; tt < 9; ++tt) {
                const LAS bf16_t* kp = Ks + (16 * (jt0 + tt) + fr) * KS_STRIDE + 8 * fq;
                const bf16x8 k0 = *(const LAS bf16x8*)kp, k1 = *(const LAS bf16x8*)(kp + 32);
                f32x4 s = __builtin_amdgcn_mfma_f32_16x16x32_bf16(k0, qf[rt][0], (f32x4){0.f, 0.f, 0.f, 0.f}, 0, 0, 0);
                S[tt] = __builtin_amdgcn_mfma_f32_16x16x32_bf16(k1, qf[rt][1], s, 0, 0, 0);
            }
            float mx = sinkl;
#pragma unroll
            for (int tt = 0; tt < 9; ++tt) {
                const bool dead = (nb == 0) && (jt0 + tt < 8);
#pragma unroll
                for (int i = 0; i < 4; ++i) {
                    const float sv = dead ? -1e30f : S[tt][i] + bm[tt][i];
                    S[tt][i] = sv; mx = fmaxf(mx, sv);
                }
            }
            mx = fmaxf(mx, __shfl_xor(mx, 16)); mx = fmaxf(mx, __shfl_xor(mx, 32));
            float l = 0.f;
#pragma unroll
            for (int tt = 0; tt < 9; ++tt)
#pragma unroll
                for (int i = 0; i < 4; ++i) { const float p = __builtin_amdgcn_exp2f(S[tt][i] - mx); S[tt][i] = p; l += p; }
            l = quad_sum(l) + __builtin_amdgcn_exp2f(sinkl - mx);
            f32x4 O[4];
#pragma unroll
            for (int dt = 0; dt < 4; ++dt) O[dt] = (f32x4){0.f, 0.f, 0.f, 0.f};
#pragma unroll
            for (int pp = 0; pp < 5; ++pp) {
                const int t0 = 2 * pp, t1 = (2 * pp + 1 < 9) ? 2 * pp + 1 : 8;
                u32x4 pw; pw.x = cvt_pk_bf16(S[t0][0], S[t0][1]); pw.y = cvt_pk_bf16(S[t0][2], S[t0][3]);
                if (pp < 4) { pw.z = cvt_pk_bf16(S[t1][0], S[t1][1]); pw.w = cvt_pk_bf16(S[t1][2], S[t1][3]); } else { pw.z = 0u; pw.w = 0u; }
                const bf16x8 pf = __builtin_bit_cast(bf16x8, pw);
#pragma unroll
                for (int dt = 0; dt < 4; ++dt) {
                    const LAS bf16_t* vp = Vt + (16 * dt + fr) * VT_STRIDE + 16 * (jt0 + t0) + 4 * fq;
                    const u32x2 lo = *(const LAS u32x2*)vp; u32x2 hi = (u32x2){0u, 0u};
                    if (pp < 4) hi = *(const LAS u32x2*)(vp + 16);
                    const u32x4 vw = (u32x4){lo.x, lo.y, hi.x, hi.y};
                    O[dt] = __builtin_amdgcn_mfma_f32_16x16x32_bf16(__builtin_bit_cast(bf16x8, vw), pf, O[dt], 0, 0, 0);
                }
            }
            const float inv = 1.0f / l;
            bf16_t* op = MIX + (rowq0 + q0 + fr) * (size_t)D + head * 64 + 4 * fq;
#pragma unroll
            for (int dt = 0; dt < 4; ++dt) { u32x2 w; w.x = cvt_pk_bf16(O[dt][0] * inv, O[dt][1] * inv); w.y = cvt_pk_bf16(O[dt][2] * inv, O[dt][3] * inv); *(u32x2*)(op + 16 * dt) = w; }
#if ATTN_SCHED_BAR
            __builtin_amdgcn_sched_barrier(0);
#endif
        }
        if (it_ + 1 < nun) ATTN_LOAD_Q(unit + ustep);
        __syncthreads();
    }
#undef ATTN_LOAD_Q
}

__device__ __forceinline__ void pool_phase(const bf16_t* Z, bf16_t* MIX, int wave, int lane, int G) {
    asm volatile("" : "+v"(lane));
    const int w = 2 << (lane >> 4);
    const int vb_ = (G == 256) ? (((int)blockIdx.x & 7) * 32 + ((int)blockIdx.x >> 3)) : (int)blockIdx.x;
    for (int seg = vb_ * 8 + wave; seg < M / 32; seg += G * 8) {
        const size_t row0 = (size_t)seg * 32; const int t0 = (int)(row0 & (SEQ - 1));
        const bf16_t* zp = Z + row0 * 512 + lane * 8;
        bf16_t* mp = MIX + row0 * D + 512 + lane * 8;
        float s[8];
#pragma unroll
        for (int e = 0; e < 8; ++e) s[e] = 0.f;
#pragma unroll
        for (int j = 1; j <= 16; ++j) {
            if (j <= w && t0 - j >= 0) {
                const u32x4 z = *(const u32x4*)(zp - (size_t)j * 512);
                s[0] += bflo(z.x); s[1] += bfhi(z.x); s[2] += bflo(z.y); s[3] += bfhi(z.y); s[4] += bflo(z.z); s[5] += bfhi(z.z); s[6] += bflo(z.w); s[7] += bfhi(z.w);
            }
        }
        for (int t8 = 0; t8 < 32; t8 += 8) {
            u32x4 zcv[8], zov[8];
#pragma unroll
            for (int j = 0; j < 8; ++j) {
                const int tt = t8 + j;
                zcv[j] = *(const u32x4*)(zp + (size_t)tt * 512);
                zov[j] = (u32x4){0u, 0u, 0u, 0u};
                if (t0 + tt - w >= 0) zov[j] = *(const u32x4*)(zp + ((long)tt - w) * 512);
            }
            asm volatile("" ::: "memory");
#pragma unroll
            for (int j = 0; j < 8; ++j) {
                const int tt = t8 + j; const u32x4 zc = zcv[j], zo = zov[j];
                const float c0 = bflo(zc.x), c1 = bfhi(zc.x), c2 = bflo(zc.y), c3 = bfhi(zc.y), c4 = bflo(zc.z), c5 = bfhi(zc.z), c6 = bflo(zc.w), c7 = bfhi(zc.w);
                s[0] += c0 - bflo(zo.x); s[1] += c1 - bfhi(zo.x); s[2] += c2 - bflo(zo.y); s[3] += c3 - bfhi(zo.y);
                s[4] += c4 - bflo(zo.z); s[5] += c5 - bfhi(zo.z); s[6] += c6 - bflo(zo.w); s[7] += c7 - bfhi(zo.w);
                const int cnt = (t0 + tt + 1 < w) ? t0 + tt + 1 : w; const float inv = 1.0f / (float)cnt;
                f32x4 o0, o1;
                o0[0] = s[0] * inv - c0; o0[1] = s[1] * inv - c1; o0[2] = s[2] * inv - c2; o0[3] = s[3] * inv - c3;
                o1[0] = s[4] * inv - c4; o1[1] = s[5] * inv - c5; o1[2] = s[6] * inv - c6; o1[3] = s[7] * inv - c7;
                *(u32x4*)(mp + (size_t)tt * D) = pack8(o0, o1);
            }
            asm volatile("" ::: "memory");
        }
    }
}

#define XB_TMO      128
#define XB_XCNT(j)  (256  + 64 * (j))
#define XB_XSUB(j)  (1280 + 64 * (j))
#define XB_XGEN(j)  (2304 + 64 * (j))
#define XB_TOP      3328
#define XB_TOPGEN   3392
#define XCD_BAR_WORDS 3456
#define XB_SPIN_CAP (1u << 18)

__device__ __forceinline__ unsigned xb_ld(unsigned* p)              { return __hip_atomic_load(p, __ATOMIC_RELAXED, __HIP_MEMORY_SCOPE_AGENT); }
__device__ __forceinline__ unsigned xb_add(unsigned* p, unsigned v) { return __hip_atomic_fetch_add(p, v, __ATOMIC_RELAXED, __HIP_MEMORY_SCOPE_AGENT); }
__device__ __forceinline__ unsigned xb_xcc_id() { return (unsigned)__builtin_amdgcn_s_getreg((3 << 11) | 20) & 0xFu; }
#define XB_SPIN(cond, bar) do { unsigned _sp = 0; while (cond) { __builtin_amdgcn_s_sleep(1); \
    if ((++_sp & 255u) == 0u) { if (xb_ld(&(bar)[XB_TMO])) break; if (_sp > XB_SPIN_CAP) { atomicAdd(&(bar)[XB_TMO], 1u); break; } } } } while (0)

struct XcdBarrier {
    unsigned* bar; unsigned x;
    volatile LAS unsigned* st;
};

__device__ __forceinline__ XcdBarrier xcd_barrier_post(unsigned* bar, volatile LAS unsigned* st) {
    XcdBarrier b; b.bar = bar; b.x = xb_xcc_id(); b.st = st;
    if (threadIdx.x == 0) (void)xb_add(&bar[XB_XCNT(b.x)], 1u);
    return b;
}
__device__ __forceinline__ void xcd_barrier_complete(unsigned* bar, unsigned x, unsigned& nloc, unsigned& nx) {
    const unsigned G = gridDim.x * gridDim.y * gridDim.z;
    unsigned sum, cnt, mine, sp = 0u;
    for (;;) {
        sum = 0u; cnt = 0u; mine = 0u;
#pragma unroll
        for (unsigned j = 0; j < 16; ++j) { const unsigned c = xb_ld(&bar[XB_XCNT(j)]); sum += c; cnt += (c > 0u) ? 1u : 0u; mine = (j == x) ? c : mine; }
        if (sum == G) break;
        __builtin_amdgcn_s_sleep(1);
        if ((++sp & 255u) == 0u) { if (xb_ld(&bar[XB_TMO])) break; if (sp > XB_SPIN_CAP) { atomicAdd(&bar[XB_TMO], 1u); break; } }
    }
    nloc = mine > 0u ? mine : 1u; nx = cnt > 0u ? cnt : 1u;
}

__device__ __forceinline__ void xcd_barrier(const XcdBarrier& b) {
    asm volatile("s_waitcnt vmcnt(0)" ::: "memory");
    __syncthreads();
    if (threadIdx.x == 0) {
        unsigned* bar = b.bar;
        __builtin_amdgcn_s_waitcnt(0);
        unsigned nloc = b.st[0], nx = b.st[1];
        if (nloc == 0u) { xcd_barrier_complete(bar, b.x, nloc, nx); b.st[0] = nloc; b.st[1] = nx; }
        const unsigned old = xb_add(&bar[XB_XSUB(b.x)], 1u);
        const unsigned gen = old / nloc;
        if (old + 1u == (gen + 1u) * nloc) {
            __builtin_amdgcn_fence(__ATOMIC_RELEASE, "agent");
            asm volatile("s_waitcnt vmcnt(0)" ::: "memory");
            const unsigned og = xb_add(&bar[XB_TOP], 1u);
            const unsigned tg = og / nx;
            if (og + 1u == (tg + 1u) * nx) xb_add(&bar[XB_TOPGEN], 1u);
            else XB_SPIN(xb_ld(&bar[XB_TOPGEN]) == tg, bar);
            __builtin_amdgcn_fence(__ATOMIC_ACQUIRE, "agent");
            xb_add(&bar[XB_XGEN(b.x)], 1u);
            asm volatile("s_waitcnt vmcnt(0)" ::: "memory");
        } else {
            XB_SPIN(xb_ld(&bar[XB_XGEN(b.x)]) == gen, bar);
            __builtin_amdgcn_fence(__ATOMIC_ACQUIRE, "agent");
            asm volatile("s_waitcnt vmcnt(0)" ::: "memory");
        }
    }
    __syncthreads();
}

__device__ __forceinline__ void group_barrier(unsigned* bar) {
    asm volatile("s_waitcnt vmcnt(0)" ::: "memory");
    __syncthreads();
    if (threadIdx.x == 0) {
        unsigned* cnt = bar + 16 * (blockIdx.x & 7u);
        __builtin_amdgcn_fence(__ATOMIC_RELEASE, "agent");
        asm volatile("s_waitcnt vmcnt(0)" ::: "memory");
        const unsigned old = xb_add(cnt, 1u), target = (old / 32u + 1u) * 32u;
        unsigned sp = 0u;
        while (xb_ld(cnt) < target) { __builtin_amdgcn_s_sleep(1); if (++sp > (1u << 22)) break; }
        __builtin_amdgcn_fence(__ATOMIC_ACQUIRE, "agent");
        asm volatile("s_waitcnt vmcnt(0)" ::: "memory");
    }
    __syncthreads();
}
__global__ void __launch_bounds__(512, 2) mega_fwd(Args a) {
    __builtin_assume(__builtin_amdgcn_workitem_id_y() == 0); __builtin_assume(__builtin_amdgcn_workitem_id_z() == 0);
    extern __shared__ __attribute__((aligned(16))) unsigned char lds_raw[];
    LAS unsigned char* lds = (LAS unsigned char*)lds_raw;
    const int tid = threadIdx.x, lane = tid & 63, wave = __builtin_amdgcn_readfirstlane(tid >> 6), G = gridDim.x;
    unsigned char* ws = a.ws;
    const int lo = a.ph_lo, hi = a.ph_hi;
#ifndef PH_MASK
#define PH_MASK 0x1ff
#endif
#define IN(k) (((PH_MASK >> (k)) & 1) && lo <= (k) && (k) < hi)
#ifndef REPEAT_MASK
#define REPEAT_MASK 0
#endif
#define NREP(k) (((REPEAT_MASK >> (k)) & 1) ? 2 : 1)
    { volatile LAS unsigned* bst0 = (volatile LAS unsigned*)(lds + LDS_MISC_OFF); if (tid < 4) bst0[tid] = 0u; }
    __syncthreads();
    (void)xcd_barrier_post((unsigned*)(ws + WS_BAR), (volatile LAS unsigned*)(lds + LDS_MISC_OFF));
    if (hi > 2 * NPHASE) cg::this_grid().sync();
#ifndef GROUP_BAR
#define GROUP_BAR 1
#endif
#define GSYNC(k) do { if (IN(k) && IN((k) + 1)) { if (GROUP_BAR && (k) > 0 && G == 256) { group_barrier((unsigned*)(ws + WS_BAR)); } else { XcdBarrier bar_; bar_.bar = (unsigned*)(ws + WS_BAR); bar_.x = xb_xcc_id(); bar_.st = (volatile LAS unsigned*)(lds + LDS_MISC_OFF); xcd_barrier(bar_); } } } while (0)
    float* ssq = (float*)(ws + WS_SSQ);
    bf16_t* XB = (bf16_t*)(ws + WS_XB); bf16_t* HB = (bf16_t*)(ws + WS_H);
    bf16_t* QB = (bf16_t*)(ws + WS_Q); bf16_t* KB = (bf16_t*)(ws + WS_K); bf16_t* VB = (bf16_t*)(ws + WS_V); bf16_t* ZB = (bf16_t*)(ws + WS_Z);
    bf16_t* MIX = (bf16_t*)(ws + WS_MIX); bf16_t* PP = (bf16_t*)(ws + WS_PP); bf16_t* PB = (bf16_t*)(ws + WS_PB);

    if (IN(0)) { for (int rep = 0; rep < NREP(0); ++rep) { prologue(a, lds, tid, wave, lane, G); if (rep + 1 < NREP(0)) __syncthreads(); } }
    GSYNC(0);
    if (IN(1)) {
        for (int rep = 0; rep < NREP(1); ++rep)
        { pg8::Gemm g{XB, (const bf16_t*)(ws + WS_WGU1), M, NGU, D}; pg8::StaticOrder S; S.init(M, NGU, G, (int)blockIdx.x);
          EpiGU E{HB, ssq}; pg8::gemm_phase<EpiGU, pg8::StaticOrder, GEMM_ALIGN, GEMM_SP2>(lds, g, S, E); }
    }
    GSYNC(1);
    if (IN(2)) {
        pg8::Gemm g{HB, (const bf16_t*)(ws + WS_WD1), M, D, FF}; pg8::StaticOrder S; S.init(M, D, G, (int)blockIdx.x, PH_REV);
        EpiRes<false> E{nullptr, XB, XB, ssq + (size_t)M, 0.5f}; pg8::gemm_phase<EpiRes<false>, pg8::StaticOrder, GEMM_ALIGN, GEMM_SP2>(lds, g, S, E);
    }
    GSYNC(2);
    if (IN(3)) for (int rep = 0; rep < NREP(3); ++rep) {
        pg8::Gemm g{XB, (const bf16_t*)(ws + WS_WIN), M, NIN, D}; pg8::StaticOrder S; S.init(M, NIN, G, (int)blockIdx.x);
        EpiWin E{QB, KB, VB, ZB, ssq + (size_t)M, inp(a, 7), inp(a, 8)}; pg8::gemm_phase<EpiWin, pg8::StaticOrder, GEMM_ALIGN, GEMM_SP2>(lds, g, S, E);
    }
    GSYNC(3);
#ifndef REP_ATTN
#define REP_ATTN 1
#endif
#ifndef REP_POOL
#define REP_POOL 1
#endif
    if (IN(4)) {
        for (int rep = 0; rep < REP_ATTN; ++rep) attn_phase(lds, QB, KB, VB, inp(a, 9), inp(a, 10), MIX, tid, wave, lane, G);
        for (int rep = 0; rep < REP_POOL; ++rep) pool_phase(ZB, MIX, wave, lane, G);
    }
    GSYNC(4);
    if (IN(5)) {
        pg8::Gemm g{MIX, (const bf16_t*)(ws + WS_WOUT), M, D, D}; pg8::StaticOrder S; S.init(M, D, G, (int)blockIdx.x);
        EpiRes<false> E{nullptr, XB, XB, ssq + 2 * (size_t)M, 1.0f}; pg8::gemm_phase<EpiRes<false>, pg8::StaticOrder, GEMM_ALIGN, GEMM_SP2>(lds, g, S, E);
    }
    GSYNC(5);
#ifndef HOT_PROBE
#define HOT_PROBE 0
#endif
#ifndef NOSTORE_PROBE
#define NOSTORE_PROBE 0
#endif
    if (IN(6)) for (int rep = 0; rep < (HOT_PROBE ? 2 : NREP(6)); ++rep) {
        pg8::Gemm g{XB, (const bf16_t*)(ws + WS_WGU2), M, NGU, D}; pg8::StaticOrder S; S.init(M, NGU, G, (int)blockIdx.x, PH_REV); if (HOT_PROBE == 1 && rep == 1) S.hot = 22;
        if (HOT_PROBE == 2) {
            if (rep == 0) { g.M = M / 2; g.N = NGU / 2; g.K = 2 * D; S.init(M / 2, NGU / 2, G, (int)blockIdx.x, 0); }
            else { XcdBarrier bar_; bar_.bar = (unsigned*)(ws + WS_BAR); bar_.x = xb_xcc_id(); bar_.st = (volatile LAS unsigned*)(lds + LDS_MISC_OFF); xcd_barrier(bar_); }
        }
        EpiGU E{HB, ssq + 2 * (size_t)M}; if (NOSTORE_PROBE && rep == 1) E.nostore = 1;
        pg8::gemm_phase<EpiGU, pg8::StaticOrder, GEMM_ALIGN, GEMM_SP2>(lds, g, S, E);
    }
    GSYNC(6);
    if (IN(7)) {
        pg8::Gemm g{HB, (const bf16_t*)(ws + WS_WD2), M, D, FF}; pg8::StaticOrder S; S.init(M, D, G, (int)blockIdx.x);
        EpiRes<false> E{nullptr, XB, XB, ssq + 3 * (size_t)M, 0.5f}; pg8::gemm_phase<EpiRes<false>, pg8::StaticOrder, GEMM_ALIGN, GEMM_SP2>(lds, g, S, E);
        { pg8::Gemm g{PB, (const bf16_t*)(ws + WS_WP), M, D, PLE}; pg8::StaticOrder S; S.init(M, D, G, (int)blockIdx.x);
          EpiPP E{PP, ssq + 4 * (size_t)M, inp(a, 21)}; pg8::gemm_phase<EpiPP, pg8::StaticOrder, GEMM_ALIGN, GEMM_SP2>(lds, g, S, E); }
    }
    GSYNC(7);
#ifndef KPROBE
#define KPROBE 0
#endif
    if (IN(8)) for (int rep = (KPROBE ? 0 : 1); rep < 2; ++rep) {
        pg8::Gemm g{XB, (const bf16_t*)(ws + WS_WG), M, D, D}; pg8::StaticOrder S; S.init(M, D, G, (int)blockIdx.x, PH_REV);
        if (KPROBE && rep == 0) { S.hot = 8; if (KPROBE == 2) { g.A = HB; g.Bt = (const bf16_t*)(ws + WS_WD2); g.K = FF; } }
        EpiGate E{a.out, XB, PP, ssq + 3 * (size_t)M, ssq + 4 * (size_t)M, inp(a, 19)}; pg8::gemm_phase<EpiGate, pg8::StaticOrder, GEMM_ALIGN, GEMM_SP2>(lds, g, S, E);
    }
#undef IN
#undef GSYNC
}

extern "C" void kernel_launch(void* const* d_in, const int* in_sizes, int n_in, void* d_out, int out_size, void* d_ws, size_t ws_size, hipStream_t stream) {
    static int grid = 0;
    if (grid == 0) {
        if (n_in != 22 || out_size != M * D || ws_size < WS_END) { fprintf(stderr, "kernel_launch: unexpected shapes (n_in %d, out %d, ws %zu)\n", n_in, out_size, ws_size); grid = -1; return; }
        int dev = 0, cus = 0, per_cu = 0;
        (void)hipGetDevice(&dev); (void)hipDeviceGetAttribute(&cus, hipDeviceAttributeMultiprocessorCount, dev);
        if (hipFuncSetAttribute((const void*)mega_fwd, hipFuncAttributeMaxDynamicSharedMemorySize, LDS_BYTES) != hipSuccess) { fprintf(stderr, "kernel_launch: hipFuncSetAttribute failed\n"); grid = -1; return; }
        if (hipOccupancyMaxActiveBlocksPerMultiprocessor(&per_cu, (const void*)mega_fwd, 512, LDS_BYTES) != hipSuccess || per_cu < 1) per_cu = 1;
        (void)hipGetLastError();
        grid = cus * per_cu;
        if (grid <= 0) grid = 256;
    }
    if (grid < 0) return;
    if (hipMemsetAsync((unsigned char*)d_ws + WS_BAR, 0, XCD_BAR_WORDS * sizeof(unsigned), stream) != hipSuccess) { fprintf(stderr, "kernel_launch: memset of the barrier words failed\n"); return; }
    Args a{};
    for (int i = 0; i < 22; ++i) a.in[i] = (const float*)d_in[i];
    a.out = (float*)d_out; a.ws = (unsigned char*)d_ws;
#if MK_N_LAUNCHES == 1
    a.ph_lo = 0; a.ph_hi = NPHASE;
    void* args[] = {&a};
    hipError_t e = hipLaunchCooperativeKernel((const void*)mega_fwd, dim3(grid), dim3(512), args, LDS_BYTES, stream);
    if (e != hipSuccess) fprintf(stderr, "cooperative launch failed: %s (grid %d)\n", hipGetErrorString(e), grid);
#else
    for (int ph = 0; ph < NPHASE; ++ph) {
        a.ph_lo = ph; a.ph_hi = ph + 1;
        hipLaunchKernelGGL(mega_fwd, dim3(grid), dim3(512), LDS_BYTES, stream, a);
    }
#endif
}
```

```cpp
#include <hip/hip_runtime.h>
#include <hip/hip_cooperative_groups.h>
#include <cstdio>
#include <cstdint>
namespace cg = cooperative_groups;
#define MK_N_LAUNCHES 1
#define PG8_WGM 8
#define PH_REV 0
#define ATTN_SCHED_BAR 0
namespace pg8 {
#define PG8_LAS __attribute__((address_space(3)))
typedef unsigned short bf16_t;
typedef short bf16x8 __attribute__((ext_vector_type(8)));
typedef float f32x4 __attribute__((ext_vector_type(4)));
typedef unsigned u32x4 __attribute__((ext_vector_type(4)));
constexpr int BM = 256, BK = 64, HALF = 128, HTB = HALF * BK * 2  , STAGE_BYTES = 8 * HTB, NXCD = 8, WGM = PG8_WGM;

__host__ __device__ __forceinline__ int lds_byte(int r, int c) { const int st = (r >> 4) * 2 + (c >> 5), rr = r & 15, cc = c & 31, ob = rr * 64 + cc * 2; return st * 1024 + (ob ^ (((ob >> 9) & 1) << 5)); }
__host__ __device__ __forceinline__ void stage_rc(int b, int& R, int& C) { const int st = b / 1024, sb = b % 1024, swz = sb ^ (((sb >> 9) & 1) << 5); R = (st >> 1) * 16 + swz / 64; C = (st & 1) * 32 + (swz % 64) / 2; }
__host__ __device__ __forceinline__ int perm32(int rho) { const int n = rho >> 4, i = rho & 15; return 8 * (i >> 2) + 4 * n + (i & 3); }

struct Unit { int pm, pn; };
struct Gemm { const bf16_t* A; const bf16_t* Bt; int M, N, K; };

struct StaticOrder {
    int nM, nN, nwg, G, c, rev, hot = 0;
    __host__ __device__ void init(int M, int N, int G_, int c_, int rev_ = 0) { nM = M / BM; nN = N / BM; nwg = nM * nN; G = G_; c = c_; rev = (rev_ && (nwg % G_) == 0) ? 1 : 0; }
    __host__ __device__ bool next(int i, Unit& u) const {
        if (hot) { if (i >= hot) return false; u.pm = 0; u.pn = i % nN; return true; }
        int ii = i; if (rev) { const int nr = nwg / G; if (i >= nr) return false; ii = nr - 1 - i; }
        const long L = (long)ii * G + c; if (L >= nwg) return false;
        int wgid = (int)L; { const int q = nwg / NXCD, r = nwg % NXCD, xcd = wgid % NXCD, off = wgid / NXCD; wgid = (xcd < r ? xcd * (q + 1) : r * (q + 1) + (xcd - r) * q) + off; }
        const int nig = WGM * nN, gid = wgid / nig, fm = gid * WGM, gsz = (nM - fm) < WGM ? (nM - fm) : WGM;
        u.pm = fm + ((wgid % nig) % gsz); u.pn = (wgid % nig) / gsz; return true;
    }
    __device__ __forceinline__ void a_ready(const Unit&) const {}
    __device__ __forceinline__ void done(const Unit&) const {}
};

__device__ __forceinline__ unsigned cvt_pk_bf16(float lo, float hi) { unsigned r; asm volatile("v_cvt_pk_bf16_f32 %0, %1, %2" : "=v"(r) : "v"(lo), "v"(hi)); return r; }
typedef float f32x2 __attribute__((ext_vector_type(2)));
template <class Epi, class Sched, bool ALIGN_EPI = false, bool SP2 = false>
__device__ __forceinline__ void gemm_phase(PG8_LAS unsigned char* lds, const Gemm g, const Sched& S, const Epi& E) {
    const int tid = threadIdx.x, wid = __builtin_amdgcn_readfirstlane(tid >> 6), lane = tid & 63, wr = wid >> 2, wc = wid & 3, fr = lane & 15, fq = lane >> 4;
    const int K = g.K, nt = K / BK;
    unsigned voffA[2], voffB[2];
#pragma unroll
    for (int i = 0; i < 2; ++i) { int R, C; stage_rc(tid * 16 + i * 8192, R, C); const int Rb = Epi::PERM ? ((R & ~31) + perm32(R & 31)) : R;
        voffA[i] = (unsigned)(R * K + C) * 2u; voffB[i] = (unsigned)(Rb * K + C) * 2u; }
    const size_t kstep = (size_t)(BK * 2);
    const size_t hstep = (size_t)HALF * K * 2;
    const size_t tstep = 2 * hstep;
    const unsigned ldsw = (unsigned)wid * 1024u;
    const int aoff = lds_byte(wr * 64 + fr, fq * 8), boff = lds_byte(wc * 32 + fr, fq * 8);
#define PG8_SA(b, h) (((b) * 2 + (h)) * HTB)
#define PG8_SB(b, h) ((4 + (b) * 2 + (h)) * HTB)
#define PG8_STAGE(bufoff, gbase, voff) do { _Pragma("unroll") for (int _i = 0; _i < 2; ++_i) \
        __builtin_amdgcn_global_load_lds((const unsigned*)((const char*)(gbase) + (voff)[_i]), (PG8_LAS unsigned*)(lds + (bufoff) + ldsw + _i * 8192), 16, 0, 0); } while (0)
#define PG8_LDA(dst, b, h) do { _Pragma("unroll") for (int m = 0; m < 4; ++m) _Pragma("unroll") for (int k = 0; k < 2; ++k) dst[m][k] = *(const PG8_LAS bf16x8*)(lds + PG8_SA(b, h) + aoff + m * 2048 + k * 1024); } while (0)
#define PG8_LDB(dst, b, h) do { _Pragma("unroll") for (int n = 0; n < 2; ++n) _Pragma("unroll") for (int k = 0; k < 2; ++k) dst[n][k] = *(const PG8_LAS bf16x8*)(lds + PG8_SB(b, h) + boff + n * 2048 + k * 1024); } while (0)
#define PG8_MMA(ai, bj, At, Bt) do { __builtin_amdgcn_s_setprio(1); _Pragma("unroll") for (int m = 0; m < 4; ++m) _Pragma("unroll") for (int n = 0; n < 2; ++n) _Pragma("unroll") for (int k = 0; k < 2; ++k) \
        acc[ai][bj][m][n] = __builtin_amdgcn_mfma_f32_16x16x32_bf16(Bt[n][k], At[m][k], acc[ai][bj][m][n], 0, 0, 0); __builtin_amdgcn_s_setprio(0); } while (0)
#define PG8_WAIT_V(n) asm volatile("s_waitcnt vmcnt(" #n ")" ::: "memory")
#define PG8_WAIT_L(n) asm volatile("s_waitcnt lgkmcnt(" #n ")" ::: "memory")
#define PG8_BAR __builtin_amdgcn_s_barrier()
#define PG8_SCHED __builtin_amdgcn_sched_barrier(0)
    Unit cur, nxt; int ui = 0;
    if (!S.next(0, cur)) return;
    f32x4 acc[2][2][4][2];
#pragma unroll
    for (int a = 0; a < 2; ++a)
#pragma unroll
        for (int b = 0; b < 2; ++b)
#pragma unroll
            for (int m = 0; m < 4; ++m)
#pragma unroll
                for (int n = 0; n < 2; ++n) acc[a][b][m][n] = (f32x4){0.f, 0.f, 0.f, 0.f};
    bf16x8 At[4][2], B0[2][2], B1[2][2];
    const char* cA = (const char*)g.A + (size_t)cur.pm * tstep; const char* cB = (const char*)g.Bt + (size_t)cur.pn * tstep;
    S.a_ready(cur);
    if constexpr (SP2) {
        PG8_STAGE(PG8_SB(0, 0), cB, voffB); PG8_STAGE(PG8_SB(0, 1), cB + hstep, voffB); PG8_STAGE(PG8_SA(0, 0), cA, voffA); PG8_STAGE(PG8_SA(0, 1), cA + hstep, voffA);
        if (wr == 1) PG8_BAR;
        PG8_WAIT_V(2); PG8_BAR;
        PG8_STAGE(PG8_SB(1, 0), cB + kstep, voffB); PG8_STAGE(PG8_SA(1, 0), cA + kstep, voffA); PG8_STAGE(PG8_SB(1, 1), cB + hstep + kstep, voffB);
        PG8_WAIT_V(6); PG8_BAR;
    } else {
        PG8_STAGE(PG8_SB(0, 0), cB, voffB); PG8_STAGE(PG8_SA(0, 0), cA, voffA); PG8_STAGE(PG8_SB(0, 1), cB + hstep, voffB); PG8_STAGE(PG8_SA(0, 1), cA + hstep, voffA);
        if (wr == 1) PG8_BAR;
        PG8_WAIT_V(4); PG8_BAR;
        PG8_STAGE(PG8_SB(1, 0), cB + kstep, voffB); PG8_STAGE(PG8_SA(1, 0), cA + kstep, voffA); PG8_STAGE(PG8_SB(1, 1), cB + hstep + kstep, voffB);
        PG8_WAIT_V(6); PG8_BAR;
    }
    for (;;) {
        const bool has_next = S.next(ui + 1, nxt);
        const char* nA = has_next ? (const char*)g.A + (size_t)nxt.pm * tstep : cA; const char* nB = has_next ? (const char*)g.Bt + (size_t)nxt.pn * tstep : cB;
        for (int t = 0; t < nt; t += 2) {
            const bool last = (t == nt - 2);
            const char* a1 = cA + (size_t)(t + 1) * kstep;
            const char* a2 = last ? nA : cA + (size_t)(t + 2) * kstep; const char* b2 = last ? nB : cB + (size_t)(t + 2) * kstep;
            const char* a3 = a2 + kstep; const char* b3 = b2 + kstep;
            if (last && has_next) S.a_ready(nxt);
            if constexpr (SP2) {
            PG8_LDB(B0, 0, 0); PG8_LDB(B1, 0, 1); PG8_SCHED; PG8_LDA(At, 0, 0); PG8_STAGE(PG8_SA(1, 1), a1 + hstep, voffA);
            PG8_WAIT_V(8); PG8_WAIT_L(0); PG8_BAR; PG8_MMA(0, 0, At, B0); PG8_MMA(0, 1, At, B1); PG8_BAR; PG8_SCHED;
            PG8_LDA(At, 0, 1); PG8_STAGE(PG8_SB(0, 0), b2, voffB); PG8_STAGE(PG8_SB(0, 1), b2 + hstep, voffB); PG8_STAGE(PG8_SA(0, 0), a2, voffA);
            PG8_WAIT_V(8); PG8_WAIT_L(0); PG8_BAR; PG8_MMA(1, 0, At, B0); PG8_MMA(1, 1, At, B1); PG8_BAR; PG8_SCHED;
            PG8_LDB(B0, 1, 0); PG8_LDB(B1, 1, 1); PG8_SCHED; PG8_LDA(At, 1, 0); PG8_STAGE(PG8_SA(0, 1), a2 + hstep, voffA);
            PG8_WAIT_V(8); PG8_WAIT_L(0); PG8_BAR; PG8_MMA(0, 0, At, B0); PG8_MMA(0, 1, At, B1); PG8_BAR; PG8_SCHED;
            PG8_LDA(At, 1, 1); PG8_STAGE(PG8_SB(1, 0), b3, voffB); PG8_STAGE(PG8_SB(1, 1), b3 + hstep, voffB); PG8_STAGE(PG8_SA(1, 0), a3, voffA);
            PG8_WAIT_V(8); PG8_WAIT_L(0); PG8_BAR; PG8_MMA(1, 0, At, B0); PG8_MMA(1, 1, At, B1); PG8_BAR; PG8_SCHED;
            } else {
            PG8_LDB(B0, 0, 0); PG8_SCHED; PG8_LDA(At, 0, 0); PG8_STAGE(PG8_SA(1, 1), a1 + hstep, voffA);
            PG8_WAIT_L(8); PG8_BAR; PG8_WAIT_L(0); PG8_MMA(0, 0, At, B0); PG8_BAR; PG8_SCHED;
            PG8_LDB(B1, 0, 1); PG8_STAGE(PG8_SB(0, 0), b2, voffB);
            PG8_BAR; PG8_WAIT_L(0); PG8_MMA(0, 1, At, B1); PG8_BAR;
            PG8_LDA(At, 0, 1); PG8_STAGE(PG8_SA(0, 0), a2, voffA);
            PG8_BAR; PG8_WAIT_L(0); PG8_MMA(1, 0, At, B0); PG8_BAR; PG8_SCHED;
            PG8_STAGE(PG8_SB(0, 1), b2 + hstep, voffB);
            PG8_WAIT_V(6); PG8_BAR; PG8_MMA(1, 1, At, B1); PG8_BAR;
            PG8_LDB(B0, 1, 0); PG8_SCHED; PG8_LDA(At, 1, 0); PG8_STAGE(PG8_SA(0, 1), a2 + hstep, voffA);
            PG8_WAIT_L(8); PG8_BAR; PG8_WAIT_L(0); PG8_MMA(0, 0, At, B0); PG8_BAR; PG8_SCHED;
            PG8_LDB(B1, 1, 1); PG8_STAGE(PG8_SB(1, 0), b3, voffB);
            PG8_BAR; PG8_WAIT_L(0); PG8_MMA(0, 1, At, B1); PG8_BAR;
            PG8_LDA(At, 1, 1); PG8_STAGE(PG8_SA(1, 0), a3, voffA);
            PG8_BAR; PG8_WAIT_L(0); PG8_MMA(1, 0, At, B0); PG8_BAR; PG8_SCHED;
            PG8_STAGE(PG8_SB(1, 1), b3 + hstep, voffB);
            PG8_WAIT_V(6); PG8_BAR; PG8_MMA(1, 1, At, B1); PG8_BAR;
            }
        }
        if constexpr (ALIGN_EPI) { if (wr == 0) PG8_BAR; }
        if constexpr (!Epi::AFTER_DRAIN) { E(acc, cur, wr, wc, fr, fq); S.done(cur); }
        if (!has_next) break;
#pragma unroll
        for (int a = 0; a < 2; ++a)
#pragma unroll
            for (int b = 0; b < 2; ++b)
#pragma unroll
                for (int m = 0; m < 4; ++m)
#pragma unroll
                    for (int n = 0; n < 2; ++n) acc[a][b][m][n] = (f32x4){0.f, 0.f, 0.f, 0.f};
        cur = nxt; cA = nA; cB = nB; ++ui;
        if constexpr (ALIGN_EPI) { if (wr == 1) PG8_BAR; }
    }
    PG8_WAIT_V(0);
    if constexpr (!ALIGN_EPI) { if (wr == 0) PG8_BAR; }
    PG8_BAR;
    if constexpr (Epi::AFTER_DRAIN) { E.fused(acc, cur, wr, wc, fr, fq, lds, wid, lane); S.done(cur); }
#undef PG8_SA
#undef PG8_SB
#undef PG8_STAGE
#undef PG8_LDA
#undef PG8_LDB
#undef PG8_MMA
#undef PG8_WAIT_V
#undef PG8_WAIT_L
#undef PG8_BAR
#undef PG8_SCHED
}
}

#ifndef MK_N_LAUNCHES
#define MK_N_LAUNCHES 1
#endif
#ifndef ATTN_SCHED_BAR
#define ATTN_SCHED_BAR 1
#endif
#ifndef PH_REV
#define PH_REV 1
#endif
#ifndef GEMM_ALIGN
#define GEMM_ALIGN true
#endif
#ifndef GEMM_SP2
#define GEMM_SP2 true
#endif
constexpr int BATCH = 32, SEQ = 2048, M = BATCH * SEQ, D = 1024, FF = 2816, NGU = 2 * FF, NIN = 1280, PLE = 256;
constexpr float EPS = 1e-6f, LOG2E = 1.4426950408889634f;
constexpr int NPHASE = 9;

#define LAS __attribute__((address_space(3)))
using pg8::bf16_t; using pg8::bf16x8; using pg8::f32x4; using pg8::u32x4; using pg8::Unit; using pg8::cvt_pk_bf16;
typedef short s16x4 __attribute__((ext_vector_type(4)));
typedef unsigned u32x2 __attribute__((ext_vector_type(2)));

constexpr size_t MiB = 1u << 20;
constexpr size_t WS_SSQ = 0;
constexpr size_t WS_BAR = 1536 * 1024;
constexpr size_t WS_WGU1 = 2 * MiB, WS_WD1 = 13 * MiB, WS_WIN = 19 * MiB, WS_WOUT = 22 * MiB, WS_WGU2 = 24 * MiB, WS_WD2 = 35 * MiB, WS_WG = 41 * MiB, WS_WP = 43 * MiB;
constexpr size_t WS_XB = 64 * MiB;
constexpr size_t WS_H = 192 * MiB;
constexpr size_t WS_Q = 544 * MiB, WS_K = 608 * MiB, WS_V = 624 * MiB, WS_Z = 640 * MiB, WS_MIX = 704 * MiB, WS_PP = 832 * MiB, WS_PB = 960 * MiB, WS_END = 992 * MiB;

constexpr int LDS_BYTES = 147456;
constexpr int LDS_MISC_OFF = 131072 + 64;
constexpr int KS_STRIDE = 72, VT_STRIDE = 264;
constexpr int ATT_K_OFF = 0, ATT_V_OFF = 256 * KS_STRIDE * 2, ATT_B_OFF = ATT_V_OFF + 64 * VT_STRIDE * 2;

__device__ __forceinline__ unsigned f2bf(float f) { unsigned u = __builtin_bit_cast(unsigned, f); return (u + 0x7fffu + ((u >> 16) & 1u)) >> 16; }
__device__ __forceinline__ unsigned pk2(float lo, float hi) { return f2bf(lo) | (f2bf(hi) << 16); }
__device__ __forceinline__ float bflo(unsigned w) { return __uint_as_float(w << 16); }
__device__ __forceinline__ float bfhi(unsigned w) { return __uint_as_float(w & 0xffff0000u); }
__device__ __forceinline__ float rs_of(float ssq, float invn) { return __builtin_amdgcn_rsqf(ssq * invn + EPS); }
__device__ __forceinline__ float sigmoid_f(float a) { return __builtin_amdgcn_rcpf(1.0f + __builtin_amdgcn_exp2f(-a * LOG2E)); }
__device__ __forceinline__ float dot4(f32x4 v) { return (v[0] * v[0] + v[1] * v[1]) + (v[2] * v[2] + v[3] * v[3]); }
__device__ __forceinline__ float quad_sum(float s) { s += __shfl_xor(s, 16); s += __shfl_xor(s, 32); return s; }
__device__ __forceinline__ float wave_sum(float v) {
#pragma unroll
    for (int o = 1; o < 64; o <<= 1) v += __shfl_xor(v, o);
    return v;
}
__device__ __forceinline__ u32x4 pack8(f32x4 a, f32x4 b) { u32x4 w; w.x = cvt_pk_bf16(a[0], a[1]); w.y = cvt_pk_bf16(a[2], a[3]); w.z = cvt_pk_bf16(b[0], b[1]); w.w = cvt_pk_bf16(b[2], b[3]); return w; }

struct EpiGU {
    static constexpr bool PERM = true, AFTER_DRAIN = false;
    bf16_t* H; const float* ssq; int nostore = 0;
    __device__ __forceinline__ void operator()(const f32x4 (&acc)[2][2][4][2], const Unit& u, int wr, int wc, int fr, int fq) const {
        typedef float f32x2 __attribute__((ext_vector_type(2)));
        const int row0 = u.pm * 256 + wr * 64 + fr, col0 = u.pn * 128 + wc * 32 + 8 * fq;
        float rsv[2][4];
#pragma unroll
        for (int ai = 0; ai < 2; ++ai)
#pragma unroll
            for (int m = 0; m < 4; ++m) rsv[ai][m] = ssq[row0 + ai * 128 + m * 16];
        asm volatile("" ::: "memory");
#pragma unroll
        for (int ai = 0; ai < 2; ++ai)
#pragma unroll
            for (int m = 0; m < 4; ++m) {
                const int row = row0 + ai * 128 + m * 16;
                const float rs = rs_of(rsv[ai][m], 1.0f / D);
                const float nrs = -rs * LOG2E, rs2 = rs * rs;
                f32x4 h[2];
#pragma unroll
                for (int n = 0; n < 2; ++n)
#pragma unroll
                    for (int hh = 0; hh < 2; ++hh) {
                        const f32x2 g = (f32x2){acc[ai][0][m][n][2 * hh], acc[ai][0][m][n][2 * hh + 1]}, uu = (f32x2){acc[ai][1][m][n][2 * hh], acc[ai][1][m][n][2 * hh + 1]};
                        const f32x2 t = g * nrs; f32x2 e; e.x = __builtin_amdgcn_exp2f(t.x); e.y = __builtin_amdgcn_exp2f(t.y);
                        const f32x2 d = e + 1.0f; f32x2 r; r.x = __builtin_amdgcn_rcpf(d.x); r.y = __builtin_amdgcn_rcpf(d.y);
                        const f32x2 o = (g * uu) * (r * rs2);
                        h[n][2 * hh] = o.x; h[n][2 * hh + 1] = o.y;
                    }
                const u32x4 hw = pack8(h[0], h[1]);
                if (!nostore) *(u32x4*)(H + (size_t)row * FF + col0) = hw;
                else asm volatile("" :: "v"(hw));
            }
    }
};
template <bool BASE_F32> struct EpiRes {
    static constexpr bool PERM = true, AFTER_DRAIN = false;
    const float* basef; const bf16_t* baseb; bf16_t* xb; float* ssq; float alpha;
    __device__ __forceinline__ void operator()(const f32x4 (&acc)[2][2][4][2], const Unit& u, int wr, int wc, int fr, int fq) const {
        const int row0 = u.pm * 256 + wr * 64 + fr, col0 = u.pn * 256 + wc * 32 + 8 * fq;
#pragma unroll
        for (int ai = 0; ai < 2; ++ai) {
            f32x4 b[4][2][2];
#pragma unroll
            for (int m = 0; m < 4; ++m)
#pragma unroll
                for (int bj = 0; bj < 2; ++bj) {
                    const size_t off = (size_t)(row0 + ai * 128 + m * 16) * D + col0 + bj * 128;
                    if constexpr (BASE_F32) { b[m][bj][0] = *(const f32x4*)(basef + off); b[m][bj][1] = *(const f32x4*)(basef + off + 4); }
                    else { const u32x4 w = *(const u32x4*)(baseb + off); b[m][bj][0] = __builtin_bit_cast(f32x4, w); }
                }
            asm volatile("" ::: "memory");
#pragma unroll
            for (int m = 0; m < 4; ++m) {
                const int row = row0 + ai * 128 + m * 16; float s = 0.f;
#pragma unroll
                for (int bj = 0; bj < 2; ++bj) {
                    const size_t off = (size_t)row * D + col0 + bj * 128;
                    f32x4 b0, b1;
                    if constexpr (BASE_F32) { b0 = b[m][bj][0]; b1 = b[m][bj][1]; }
                    else { const u32x4 w = __builtin_bit_cast(u32x4, b[m][bj][0]); b0 = (f32x4){bflo(w.x), bfhi(w.x), bflo(w.y), bfhi(w.y)}; b1 = (f32x4){bflo(w.z), bfhi(w.z), bflo(w.w), bfhi(w.w)}; }
                    const f32x4 v0 = b0 + acc[ai][bj][m][0] * alpha, v1 = b1 + acc[ai][bj][m][1] * alpha;
                    *(u32x4*)(xb + off) = pack8(v0, v1);
                    s += dot4(v0) + dot4(v1);
                }
                s = quad_sum(s);
                if (fq == 0) unsafeAtomicAdd(ssq + row, s);
            }
            asm volatile("" ::: "memory");
        }
    }
};
struct EpiWin {
    static constexpr bool PERM = true, AFTER_DRAIN = false;
    bf16_t *Q, *K, *V, *Z; const float* ssq; const float* qg; const float* kg;
    __device__ __forceinline__ void operator()(const f32x4 (&acc)[2][2][4][2], const Unit& u, int wr, int wc, int fr, int fq) const {
        const int row0 = u.pm * 256 + wr * 64 + fr, pn = u.pn;
        const bool normed = (pn < 2) || (pn == 2 && wc < 2);
        f32x4 ggn[2][2];
        { const float* gn = (pn < 2) ? qg : kg;
#pragma unroll
          for (int bj = 0; bj < 2; ++bj)
#pragma unroll
              for (int n = 0; n < 2; ++n) ggn[bj][n] = normed ? *(const f32x4*)(gn + bj * 32 + 8 * fq + 4 * n) : (f32x4){1.f, 1.f, 1.f, 1.f}; }
        float rsv[2][4];
#pragma unroll
        for (int ai = 0; ai < 2; ++ai)
#pragma unroll
            for (int m = 0; m < 4; ++m) rsv[ai][m] = ssq[row0 + ai * 128 + m * 16];
        asm volatile("" ::: "memory");
#pragma unroll
        for (int ai = 0; ai < 2; ++ai)
#pragma unroll
            for (int m = 0; m < 4; ++m) {
                const int row = row0 + ai * 128 + m * 16;
                const float rs = rs_of(rsv[ai][m], 1.0f / D);
                f32x4 v[2][2];
#pragma unroll
                for (int bj = 0; bj < 2; ++bj)
#pragma unroll
                    for (int n = 0; n < 2; ++n) v[bj][n] = acc[ai][bj][m][n] * rs;
                if (normed) {
                    float s = (dot4(v[0][0]) + dot4(v[0][1])) + (dot4(v[1][0]) + dot4(v[1][1]));
                    s = quad_sum(s);
                    const float rq = rs_of(s, 1.0f / 64.0f);
                    const float sc = (pn < 2) ? rq * (0.125f * LOG2E) : rq;
#pragma unroll
                    for (int bj = 0; bj < 2; ++bj)
#pragma unroll
                        for (int n = 0; n < 2; ++n) v[bj][n] = v[bj][n] * ggn[bj][n] * sc;
                }
                bf16_t* p;
                if (pn < 2) p = Q + (size_t)row * 512 + (pn * 4 + wc) * 64;
                else if (pn == 2) p = (wc < 2) ? K + (size_t)row * 128 + wc * 64 : V + (size_t)row * 128 + (wc - 2) * 64;
                else p = Z + (size_t)row * 512 + (pn - 3) * 256 + wc * 64;
#pragma unroll
                for (int bj = 0; bj < 2; ++bj) *(u32x4*)(p + bj * 32 + 8 * fq) = pack8(v[bj][0], v[bj][1]);
            }
    }
};
struct EpiPP {
    static constexpr bool PERM = true, AFTER_DRAIN = false;
    bf16_t* PP; float* ssq; const float* pg;
    __device__ __forceinline__ void operator()(const f32x4 (&acc)[2][2][4][2], const Unit& u, int wr, int wc, int fr, int fq) const {
        const int row0 = u.pm * 256 + wr * 64 + fr, col0 = u.pn * 256 + wc * 32 + 8 * fq;
        f32x4 gg[2][2];
#pragma unroll
        for (int bj = 0; bj < 2; ++bj)
#pragma unroll
            for (int n = 0; n < 2; ++n) gg[bj][n] = *(const f32x4*)(pg + col0 + bj * 128 + 4 * n);
        asm volatile("" ::: "memory");
#pragma unroll
        for (int ai = 0; ai < 2; ++ai)
#pragma unroll
            for (int m = 0; m < 4; ++m) {
                const int row = row0 + ai * 128 + m * 16; float s = 0.f;
#pragma unroll
                for (int bj = 0; bj < 2; ++bj) {
                    const size_t off = (size_t)row * D + col0 + bj * 128;
                    *(u32x4*)(PP + off) = pack8(acc[ai][bj][m][0] * gg[bj][0], acc[ai][bj][m][1] * gg[bj][1]);
                    s += dot4(acc[ai][bj][m][0]) + dot4(acc[ai][bj][m][1]);
                }
                s = quad_sum(s);
                if (fq == 0) unsafeAtomicAdd(ssq + row, s);
            }
    }
};
struct EpiGate {
    static constexpr bool PERM = true, AFTER_DRAIN = false;
    float* OUT; const bf16_t* XBs; const bf16_t* PP; const float *ssq3, *ssqE, *bg;
    __device__ __forceinline__ void operator()(const f32x4 (&acc)[2][2][4][2], const Unit& u, int wr, int wc, int fr, int fq) const {
        typedef float f32x2 __attribute__((ext_vector_type(2)));
        const int row0 = u.pm * 256 + wr * 64 + fr, col0 = u.pn * 256 + wc * 32 + 8 * fq;
        f32x4 bb[2][2];
#pragma unroll
        for (int bj = 0; bj < 2; ++bj)
#pragma unroll
            for (int n = 0; n < 2; ++n) bb[bj][n] = *(const f32x4*)(bg + col0 + bj * 128 + 4 * n);
        u32x4 xw[2][2], pw[2][2]; float s3[2], sE[2];
#define EG_LOAD(buf, b) do { const int row = row0 + ((b) >> 2) * 128 + ((b) & 3) * 16; s3[buf] = ssq3[row]; sE[buf] = ssqE[row]; \
            _Pragma("unroll") for (int bj = 0; bj < 2; ++bj) { const size_t off = (size_t)row * D + col0 + bj * 128; xw[buf][bj] = *(const u32x4*)(XBs + off); pw[buf][bj] = *(const u32x4*)(PP + off); } } while (0)
        EG_LOAD(0, 0);
#pragma unroll
        for (int b = 0; b < 8; ++b) {
            const int cb = b & 1, ai = b >> 2, m = b & 3;
            if (b + 1 < 8) { if (cb == 0) EG_LOAD(1, b + 1); else EG_LOAD(0, b + 1); }
            asm volatile("" ::: "memory");
            const float r3 = rs_of(s3[cb], 1.0f / D), rE = rs_of(sE[cb], 1.0f / D), nr3 = -r3 * LOG2E;
#pragma unroll
            for (int bj = 0; bj < 2; ++bj) {
                const size_t off = (size_t)(row0 + ai * 128 + m * 16) * D + col0 + bj * 128;
                const unsigned pws[4] = {pw[cb][bj].x, pw[cb][bj].y, pw[cb][bj].z, pw[cb][bj].w}, xws[4] = {xw[cb][bj].x, xw[cb][bj].y, xw[cb][bj].z, xw[cb][bj].w};
                f32x4 o[2];
#pragma unroll
                for (int h = 0; h < 4; ++h) {
                    const int n = h >> 1, i0 = 2 * (h & 1);
                    const f32x2 ac = (f32x2){acc[ai][bj][m][n][i0], acc[ai][bj][m][n][i0 + 1]}, bv = (f32x2){bb[bj][n][i0], bb[bj][n][i0 + 1]};
                    const f32x2 t = ac * nr3 - bv * LOG2E; f32x2 ex; ex.x = __builtin_amdgcn_exp2f(t.x); ex.y = __builtin_amdgcn_exp2f(t.y);
                    const f32x2 dd = ex + 1.0f; f32x2 r; r.x = __builtin_amdgcn_rcpf(dd.x); r.y = __builtin_amdgcn_rcpf(dd.y);
                    const f32x2 ev = (f32x2){bflo(pws[h]), bfhi(pws[h])}, xv = (f32x2){bflo(xws[h]), bfhi(xws[h])};
                    const f32x2 ov = xv + r * (ev * rE);
                    o[n][i0] = ov.x; o[n][i0 + 1] = ov.y;
                }
                *(f32x4*)(OUT + off) = o[0]; *(f32x4*)(OUT + off + 4) = o[1];
            }
            asm volatile("" ::: "memory");
        }
#undef EG_LOAD
    }
};

__device__ __forceinline__ void transpose_item(const float* W, int ldw, int K, const float* gain, bf16_t* WT, int k0, int c0, int j0, LAS float* scr, int lane) {
    float v[32];
#pragma unroll
    for (int i = 0; i < 32; ++i) { const int kk = 2 * i + (lane >> 5); v[i] = W[(size_t)(k0 + kk) * ldw + c0 + (lane & 31)]; }
#pragma unroll
    for (int i = 0; i < 32; ++i) { const int kk = 2 * i + (lane >> 5); scr[kk * 33 + (lane & 31)] = v[i]; }
    asm volatile("s_waitcnt lgkmcnt(0)" ::: "memory");
    const int c = lane & 7;
    f32x4 g0 = (f32x4){1.f, 1.f, 1.f, 1.f}, g1 = g0;
    if (gain) { g0 = *(const f32x4*)(gain + k0 + 8 * c); g1 = *(const f32x4*)(gain + k0 + 8 * c + 4); }
#pragma unroll
    for (int j = 0; j < 4; ++j) { const int n = (lane >> 3) + 8 * j; const LAS float* s = scr + (8 * c) * 33 + n;
        u32x4 o; o.x = pk2(s[0 * 33] * g0[0], s[1 * 33] * g0[1]); o.y = pk2(s[2 * 33] * g0[2], s[3 * 33] * g0[3]); o.z = pk2(s[4 * 33] * g1[0], s[5 * 33] * g1[1]); o.w = pk2(s[6 * 33] * g1[2], s[7 * 33] * g1[3]);
        *(u32x4*)(WT + (size_t)(j0 + n) * K + k0 + 8 * c) = o; }
    asm volatile("s_waitcnt lgkmcnt(0)" ::: "memory");
}
__device__ __forceinline__ int cmap_gu(int j0) { const int pn = j0 >> 8, r = j0 & 255; return ((r >> 7) ? FF : 0) + 128 * pn + (r & 127); }
__device__ __forceinline__ int cmap_win(int j0) { const int pn = j0 >> 8, r = j0 & 255; return 256 * pn + 64 * ((r & 127) >> 5) + 32 * (r >> 7); }

struct Args {
    const float* in[22]; float* out; unsigned char* ws; int ph_lo, ph_hi;
};
__device__ __forceinline__ const float* inp(const Args& a, int k) { asm volatile("" : "+s"(k)); return a.in[k]; }

__device__ __forceinline__ void prologue(const Args& a, LAS unsigned char* lds, int tid, int wave, int lane, int G) {
    unsigned char* ws = a.ws;
    LAS float* scr = (LAS float*)(lds + (wave & 3) * 16384);
    const bool xform = wave < 4;
    const int gw = blockIdx.x * 4 + (wave & 3), NGW = G * 4;
    if (xform) {
    constexpr int I_GU = (D / 64) * (NGU / 32), I_DN = (FF / 64) * (D / 32), I_WIN = (D / 64) * (768 / 32), I_SQ = (D / 64) * (D / 32), I_PR = (PLE / 64) * (D / 32);
    constexpr int NITEMS = 2 * I_GU + 2 * I_DN + I_WIN + 2 * I_SQ + I_PR;
    for (int it = gw; it < NITEMS; it += NGW) {
        int r = it;
        if (r < I_GU) { const int nb = NGU / 32, kb = r / nb, jb = r % nb; transpose_item(inp(a, 3), NGU, D, inp(a, 2), (bf16_t*)(ws + WS_WGU1), 64 * kb, cmap_gu(32 * jb), 32 * jb, scr, lane); continue; } r -= I_GU;
        if (r < I_GU) { const int nb = NGU / 32, kb = r / nb, jb = r % nb; transpose_item(inp(a, 15), NGU, D, inp(a, 14), (bf16_t*)(ws + WS_WGU2), 64 * kb, cmap_gu(32 * jb), 32 * jb, scr, lane); continue; } r -= I_GU;
        if (r < I_DN) { const int nb = D / 32, kb = r / nb, jb = r % nb; transpose_item(inp(a, 4), D, FF, nullptr, (bf16_t*)(ws + WS_WD1), 64 * kb, 32 * jb, 32 * jb, scr, lane); continue; } r -= I_DN;
        if (r < I_DN) { const int nb = D / 32, kb = r / nb, jb = r % nb; transpose_item(inp(a, 16), D, FF, nullptr, (bf16_t*)(ws + WS_WD2), 64 * kb, 32 * jb, 32 * jb, scr, lane); continue; } r -= I_DN;
        if (r < I_WIN) { const int nb = 768 / 32, kb = r / nb, jb = r % nb; transpose_item(inp(a, 6), NIN, D, inp(a, 5), (bf16_t*)(ws + WS_WIN), 64 * kb, cmap_win(32 * jb), 32 * jb, scr, lane); continue; } r -= I_WIN;
        if (r < I_SQ) { const int nb = D / 32, kb = r / nb, jb = r % nb; transpose_item(inp(a, 13), D, D, nullptr, (bf16_t*)(ws + WS_WOUT), 64 * kb, 32 * jb, 32 * jb, scr, lane); continue; } r -= I_SQ;
        if (r < I_SQ) { const int nb = D / 32, kb = r / nb, jb = r % nb; transpose_item(inp(a, 18), D, D, inp(a, 17), (bf16_t*)(ws + WS_WG), 64 * kb, 32 * jb, 32 * jb, scr, lane); continue; } r -= I_SQ;
        { const int nb = D / 32, kb = r / nb, jb = r % nb; transpose_item(inp(a, 20), D, PLE, nullptr, (bf16_t*)(ws + WS_WP), 64 * kb, 32 * jb, 32 * jb, scr, lane); }
    }
    {
        const float* w_in = inp(a, 6); const float* pool_w = inp(a, 11); const float* pscale = inp(a, 12); const float* mg = inp(a, 5);
        bf16_t* WT = (bf16_t*)(ws + WS_WIN);
        for (int it = gw; it < 4 * 128; it += NGW) {
            const int g = it >> 7, k0 = (it & 127) * 8;
            const float* pw = pool_w + g * 16384 + 2 * lane; const float* wr = w_in + (size_t)k0 * NIN + 768 + 128 * g;
            typedef float f32x2 __attribute__((ext_vector_type(2)));
            float acc[8][2];
#pragma unroll
            for (int r = 0; r < 8; ++r) { acc[r][0] = 0.f; acc[r][1] = 0.f; }
#pragma unroll 2
            for (int c = 0; c < 128; c += 4) {
                f32x2 p[4];
#pragma unroll
                for (int cc = 0; cc < 4; ++cc) p[cc] = *(const f32x2*)(pw + (c + cc) * 128);
#pragma unroll
                for (int r = 0; r < 8; ++r) {
                    const f32x4 wv = *(const f32x4*)(wr + (size_t)r * NIN + c);
#pragma unroll
                    for (int cc = 0; cc < 4; ++cc) { acc[r][0] += wv[cc] * p[cc].x; acc[r][1] += wv[cc] * p[cc].y; }
                }
            }
            const f32x4 m0 = *(const f32x4*)(mg + k0), m1 = *(const f32x4*)(mg + k0 + 4);
#pragma unroll
            for (int e = 0; e < 2; ++e) {
                const int zc = g * 128 + 2 * lane + e; const int j = 256 * (3 + (zc >> 8)) + 128 * ((zc & 63) >> 5) + 32 * ((zc & 255) >> 6) + (zc & 31);
                const float sc = pscale[zc];
                u32x4 o; o.x = pk2(acc[0][e] * m0[0] * sc, acc[1][e] * m0[1] * sc); o.y = pk2(acc[2][e] * m0[2] * sc, acc[3][e] * m0[3] * sc);
                o.z = pk2(acc[4][e] * m1[0] * sc, acc[5][e] * m1[1] * sc); o.w = pk2(acc[6][e] * m1[2] * sc, acc[7][e] * m1[3] * sc);
                *(u32x4*)(WT + (size_t)j * D + k0) = o;
            }
        }
    }
    } else {
    {
        const float* x = inp(a, 0); bf16_t* XB = (bf16_t*)(ws + WS_XB); float* ssq0 = (float*)(ws + WS_SSQ);
        for (int m = gw; m < M; m += 4 * NGW) {
            f32x4 v[4][4]; float sq[4];
#pragma unroll
            for (int r = 0; r < 4; ++r) { const int mr = m + r * NGW; const f32x4* xr = (const f32x4*)(x + (size_t)(mr < M ? mr : m) * D) + lane;
#pragma unroll
                for (int j = 0; j < 4; ++j) v[r][j] = xr[64 * j]; }
#pragma unroll
            for (int r = 0; r < 4; ++r) { float s = 0.f;
#pragma unroll
                for (int j = 0; j < 4; ++j) s += dot4(v[r][j]);
                sq[r] = wave_sum(s); }
#pragma unroll
            for (int r = 0; r < 4; ++r) { const int mr = m + r * NGW;
                if (mr < M) { u32x2* o8 = (u32x2*)(XB + (size_t)mr * D) + lane;
#pragma unroll
                    for (int j = 0; j < 4; ++j) { u32x2 w; w.x = cvt_pk_bf16(v[r][j][0], v[r][j][1]); w.y = cvt_pk_bf16(v[r][j][2], v[r][j][3]); o8[64 * j] = w; }
                    if (lane == 0) ssq0[mr] = sq[r]; } }
        }
    }
    {
        const float* p = inp(a, 1); bf16_t* PB = (bf16_t*)(ws + WS_PB);
        for (int m = gw; m < M; m += 8 * NGW) {
            f32x4 v[8];
#pragma unroll
            for (int r = 0; r < 8; ++r) { const int mr = m + r * NGW; v[r] = *((const f32x4*)(p + (size_t)(mr < M ? mr : m) * PLE) + lane); }
#pragma unroll
            for (int r = 0; r < 8; ++r) { const int mr = m + r * NGW; if (mr < M) { u32x2 w; w.x = cvt_pk_bf16(v[r][0], v[r][1]); w.y = cvt_pk_bf16(v[r][2], v[r][3]); *((u32x2*)(PB + (size_t)mr * PLE) + lane) = w; } }
        }
    }
    }
    {
        float* z = (float*)(ws + WS_SSQ) + M;
        for (int i = blockIdx.x * 512 + tid; i < 4 * M; i += G * 512) z[i] = 0.f;
    }
}

struct AttnRegs { u32x4 k[4], v[4]; };
__device__ __forceinline__ void attn_load(AttnRegs& R, const bf16_t* Q, const bf16_t* Kg, const bf16_t* Vg, int unit, int tid, int wave, int lane) {
    const int b = unit >> 5, kvh = (unit >> 4) & 1, nb = unit & 15;
    const size_t rowq0 = (size_t)b * SEQ + (size_t)nb * 128;
    const long rowk0 = (long)b * SEQ + (long)(nb - 1) * 128;
#pragma unroll
    for (int it = 0; it < 4; ++it) {
        const int idx = tid + 512 * it, key = idx & 255, ch = idx >> 8;
        R.k[it] = (u32x4){0u, 0u, 0u, 0u}; R.v[it] = (u32x4){0u, 0u, 0u, 0u};
        if (nb > 0 || key >= 128) { const size_t g = (size_t)(rowk0 + key) * 128 + kvh * 64 + ch * 8; R.k[it] = *(const u32x4*)(Kg + g); R.v[it] = *(const u32x4*)(Vg + g); }
    }
}
__device__ __forceinline__ void attn_phase(LAS unsigned char* lds, const bf16_t* Q, const bf16_t* Kg, const bf16_t* Vg, const float* rel_bias, const float* sinks, bf16_t* MIX,
                                           int tid, int wave, int lane, int G) {
    LAS bf16_t* Ks = (LAS bf16_t*)(lds + ATT_K_OFF); LAS bf16_t* Vt = (LAS bf16_t*)(lds + ATT_V_OFF); LAS float* Bt = (LAS float*)(lds + ATT_B_OFF);
    constexpr int NUNIT = BATCH * 32;
    const int nr_ = (NUNIT % G == 0 && PH_REV) ? NUNIT / G : 0;
    int unit = nr_ ? (int)blockIdx.x + (nr_ - 1) * G : (int)blockIdx.x;
    const int ustep = nr_ ? -G : G;
    if (unit >= NUNIT) return;
    AttnRegs R; attn_load(R, Q, Kg, Vg, unit, tid, wave, lane);
    bf16x8 qf[4][2];
#define ATTN_LOAD_Q(un) do { const int b_ = (un) >> 5, kvh_ = ((un) >> 4) & 1, nb_ = (un) & 15; const size_t rq_ = (size_t)b_ * SEQ + (size_t)nb_ * 128; const int head_ = kvh_ * 4 + (wave >> 1); \
        _Pragma("unroll") for (int rt = 0; rt < 4; ++rt) { const bf16_t* qp = Q + (rq_ + (wave & 1) * 64 + rt * 16 + (lane & 15)) * 512 + head_ * 64 + 8 * (lane >> 4); \
            qf[rt][0] = *(const bf16x8*)qp; qf[rt][1] = *(const bf16x8*)(qp + 32); } } while (0)
    ATTN_LOAD_Q(unit);
    int kvh_cur = -1; float sinkl = 0.f; float bm[9][4];
#pragma unroll
    for (int tt = 0; tt < 9; ++tt)
#pragma unroll
        for (int i = 0; i < 4; ++i) bm[tt][i] = 0.f;
    for (; unit >= 0 && unit < NUNIT; unit += ustep) {
        const int b = unit >> 5, kvh = (unit >> 4) & 1, nb = unit & 15;
        const size_t rowq0 = (size_t)b * SEQ + (size_t)nb * 128;
        const bool newtab = (kvh != kvh_cur);
#pragma unroll
        for (int it = 0; it < 4; ++it) {
            const int idx = tid + 512 * it, key = idx & 255, ch = idx >> 8;
            *(LAS u32x4*)(Ks + key * KS_STRIDE + ch * 8) = R.k[it];
            LAS bf16_t* vp = Vt + (ch * 8) * VT_STRIDE + key; const u32x4 vv = R.v[it];
            vp[0 * VT_STRIDE] = (bf16_t)(vv.x & 0xffffu); vp[1 * VT_STRIDE] = (bf16_t)(vv.x >> 16);
            vp[2 * VT_STRIDE] = (bf16_t)(vv.y & 0xffffu); vp[3 * VT_STRIDE] = (bf16_t)(vv.y >> 16);
            vp[4 * VT_STRIDE] = (bf16_t)(vv.z & 0xffffu); vp[5 * VT_STRIDE] = (bf16_t)(vv.z >> 16);
            vp[6 * VT_STRIDE] = (bf16_t)(vv.w & 0xffffu); vp[7 * VT_STRIDE] = (bf16_t)(vv.w >> 16);
        }
        if (newtab) {
            const int g = tid >> 7, dist = tid & 127;
            int bucket = dist;
            if (dist >= 16) { int lg = 16 + (int)(logf((float)dist / 16.0f) / logf(8.0f) * 16.0f); bucket = lg < 31 ? lg : 31; }
            Bt[tid] = rel_bias[bucket * 8 + kvh * 4 + g] * LOG2E;
        }
        __syncthreads();
        if (unit + ustep >= 0 && unit + ustep < NUNIT) attn_load(R, Q, Kg, Vg, unit + ustep, tid, wave, lane);
        const int g = wave >> 1, head = kvh * 4 + g, fr = lane & 15, fq = lane >> 4;
        if (newtab) {
            kvh_cur = kvh; sinkl = sinks[head] * LOG2E;
#pragma unroll
            for (int tt = 0; tt < 9; ++tt)
#pragma unroll
                for (int i = 0; i < 4; ++i) { const int dist = fr + 128 - 16 * tt - 4 * fq - i; bm[tt][i] = (dist >= 0 && dist < 128) ? Bt[g * 128 + (dist & 127)] : -1e30f; }
        }
#pragma unroll
        for (int rt = 0; rt < 4; ++rt) {
            const int q0 = (wave & 1) * 64 + rt * 16, jt0 = q0 >> 4;
            f32x4 S[9];
#pragma unroll
            for (int tt = 0; tt < 9; ++tt) {
                const LAS bf16_t* kp = Ks + (16 * (jt0 + tt) + fr) * KS_STRIDE + 8 * fq;
                const bf16x8 k0 = *(const LAS bf16x8*)kp, k1 = *(const LAS bf16x8*)(kp + 32);
                f32x4 s = __builtin_amdgcn_mfma_f32_16x16x32_bf16(k0, qf[rt][0], (f32x4){0.f, 0.f, 0.f, 0.f}, 0, 0, 0);
                S[tt] = __builtin_amdgcn_mfma_f32_16x16x32_bf16(k1, qf[rt][1], s, 0, 0, 0);
            }
            float mx = sinkl;
#pragma unroll
            for (int tt = 0; tt < 9; ++tt) {
                const bool dead = (nb == 0) && (jt0 + tt < 8);
#pragma unroll
                for (int i = 0; i < 4; ++i) {
                    const float sv = dead ? -1e30f : S[tt][i] + bm[tt][i];
                    S[tt][i] = sv; mx = fmaxf(mx, sv);
                }
            }
            mx = fmaxf(mx, __shfl_xor(mx, 16)); mx = fmaxf(mx, __shfl_xor(mx, 32));
            float l = 0.f;
#pragma unroll
            for (int tt = 0; tt < 9; ++tt)
#pragma unroll
                for (int i = 0; i < 4; ++i) { const float p = __builtin_amdgcn_exp2f(S[tt][i] - mx); S[tt][i] = p; l += p; }
            l = quad_sum(l) + __builtin_amdgcn_exp2f(sinkl - mx);
            f32x4 O[4];
#pragma unroll
            for (int dt = 0; dt < 4; ++dt) O[dt] = (f32x4){0.f, 0.f, 0.f, 0.f};
#pragma unroll
            for (int pp = 0; pp < 5; ++pp) {
                const int t0 = 2 * pp, t1 = (2 * pp + 1 < 9) ? 2 * pp + 1 : 8;
                u32x4 pw; pw.x = cvt_pk_bf16(S[t0][0], S[t0][1]); pw.y = cvt_pk_bf16(S[t0][2], S[t0][3]);
                if (pp < 4) { pw.z = cvt_pk_bf16(S[t1][0], S[t1][1]); pw.w = cvt_pk_bf16(S[t1][2], S[t1][3]); } else { pw.z = 0u; pw.w = 0u; }
                const bf16x8 pf = __builtin_bit_cast(bf16x8, pw);
#pragma unroll
                for (int dt = 0; dt < 4; ++dt) {
                    const LAS bf16_t* vp = Vt + (16 * dt + fr) * VT_STRIDE + 16 * (jt0 + t0) + 4 * fq;
                    const u32x2 lo = *(const LAS u32x2*)vp; u32x2 hi = (u32x2){0u, 0u};
                    if (pp < 4) hi = *(const LAS u32x2*)(vp + 16);
                    const u32x4 vw = (u32x4){lo.x, lo.y, hi.x, hi.y};
                    O[dt] = __builtin_amdgcn_mfma_f32_16x16x32_bf16(__builtin_bit_cast(bf16x8, vw), pf, O[dt], 0, 0, 0);
                }
            }
            const float inv = 1.0f / l;
            bf16_t* op = MIX + (rowq0 + q0 + fr) * (size_t)D + head * 64 + 4 * fq;
#pragma unroll
            for (int dt = 0; dt < 4; ++dt) { u32x2 w; w.x = cvt_pk_bf16(O[dt][0] * inv, O[dt][1] * inv); w.y = cvt_pk_bf16(O[dt][2] * inv, O[dt][3] * inv); *(u32x2*)(op + 16 * dt) = w; }
#if ATTN_SCHED_BAR
            __builtin_amdgcn_sched_barrier(0);
#endif
        }
        if (unit + ustep >= 0 && unit + ustep < NUNIT) ATTN_LOAD_Q(unit + ustep);
        __syncthreads();
    }
#undef ATTN_LOAD_Q
}

__device__ __forceinline__ void pool_phase(const bf16_t* Z, bf16_t* MIX, int wave, int lane, int G) {
    asm volatile("" : "+v"(lane));
    const int w = 2 << (lane >> 4);
    for (int seg = blockIdx.x * 8 + wave; seg < M / 32; seg += G * 8) {
        const size_t row0 = (size_t)seg * 32; const int t0 = (int)(row0 & (SEQ - 1));
        const bf16_t* zp = Z + row0 * 512 + lane * 8;
        bf16_t* mp = MIX + row0 * D + 512 + lane * 8;
        float s[8];
#pragma unroll
        for (int e = 0; e < 8; ++e) s[e] = 0.f;
#pragma unroll
        for (int j = 1; j <= 16; ++j) {
            if (j <= w && t0 - j >= 0) {
                const u32x4 z = *(const u32x4*)(zp - (size_t)j * 512);
                s[0] += bflo(z.x); s[1] += bfhi(z.x); s[2] += bflo(z.y); s[3] += bfhi(z.y); s[4] += bflo(z.z); s[5] += bfhi(z.z); s[6] += bflo(z.w); s[7] += bfhi(z.w);
            }
        }
        for (int t8 = 0; t8 < 32; t8 += 8) {
            u32x4 zcv[8], zov[8];
#pragma unroll
            for (int j = 0; j < 8; ++j) {
                const int tt = t8 + j;
                zcv[j] = *(const u32x4*)(zp + (size_t)tt * 512);
                zov[j] = (u32x4){0u, 0u, 0u, 0u};
                if (t0 + tt - w >= 0) zov[j] = *(const u32x4*)(zp + ((long)tt - w) * 512);
            }
            asm volatile("" ::: "memory");
#pragma unroll
            for (int j = 0; j < 8; ++j) {
                const int tt = t8 + j; const u32x4 zc = zcv[j], zo = zov[j];
                const float c0 = bflo(zc.x), c1 = bfhi(zc.x), c2 = bflo(zc.y), c3 = bfhi(zc.y), c4 = bflo(zc.z), c5 = bfhi(zc.z), c6 = bflo(zc.w), c7 = bfhi(zc.w);
                s[0] += c0 - bflo(zo.x); s[1] += c1 - bfhi(zo.x); s[2] += c2 - bflo(zo.y); s[3] += c3 - bfhi(zo.y);
                s[4] += c4 - bflo(zo.z); s[5] += c5 - bfhi(zo.z); s[6] += c6 - bflo(zo.w); s[7] += c7 - bfhi(zo.w);
                const int cnt = (t0 + tt + 1 < w) ? t0 + tt + 1 : w; const float inv = 1.0f / (float)cnt;
                f32x4 o0, o1;
                o0[0] = s[0] * inv - c0; o0[1] = s[1] * inv - c1; o0[2] = s[2] * inv - c2; o0[3] = s[3] * inv - c3;
                o1[0] = s[4] * inv - c4; o1[1] = s[5] * inv - c5; o1[2] = s[6] * inv - c6; o1[3] = s[7] * inv - c7;
                *(u32x4*)(mp + (size_t)tt * D) = pack8(o0, o1);
            }
            asm volatile("" ::: "memory");
        }
    }
}

#define XB_TMO      128
#define XB_XCNT(j)  (256  + 64 * (j))
#define XB_XSUB(j)  (1280 + 64 * (j))
#define XB_XGEN(j)  (2304 + 64 * (j))
#define XB_TOP      3328
#define XB_TOPGEN   3392
#define XCD_BAR_WORDS 3456
#define XB_SPIN_CAP (1u << 18)

__device__ __forceinline__ unsigned xb_ld(unsigned* p)              { return __hip_atomic_load(p, __ATOMIC_RELAXED, __HIP_MEMORY_SCOPE_AGENT); }
__device__ __forceinline__ unsigned xb_add(unsigned* p, unsigned v) { return __hip_atomic_fetch_add(p, v, __ATOMIC_RELAXED, __HIP_MEMORY_SCOPE_AGENT); }
__device__ __forceinline__ unsigned xb_xcc_id() { return (unsigned)__builtin_amdgcn_s_getreg((3 << 11) | 20) & 0xFu; }
#define XB_SPIN(cond, bar) do { unsigned _sp = 0; while (cond) { __builtin_amdgcn_s_sleep(1); \
    if ((++_sp & 255u) == 0u) { if (xb_ld(&(bar)[XB_TMO])) break; if (_sp > XB_SPIN_CAP) { atomicAdd(&(bar)[XB_TMO], 1u); break; } } } } while (0)

struct XcdBarrier {
    unsigned* bar; unsigned x;
    volatile LAS unsigned* st;
};

__device__ __forceinline__ XcdBarrier xcd_barrier_post(unsigned* bar, volatile LAS unsigned* st) {
    XcdBarrier b; b.bar = bar; b.x = xb_xcc_id(); b.st = st;
    if (threadIdx.x == 0) (void)xb_add(&bar[XB_XCNT(b.x)], 1u);
    return b;
}
__device__ __forceinline__ void xcd_barrier_complete(unsigned* bar, unsigned x, unsigned& nloc, unsigned& nx) {
    const unsigned G = gridDim.x * gridDim.y * gridDim.z;
    unsigned sum, cnt, mine, sp = 0u;
    for (;;) {
        sum = 0u; cnt = 0u; mine = 0u;
#pragma unroll
        for (unsigned j = 0; j < 16; ++j) { const unsigned c = xb_ld(&bar[XB_XCNT(j)]); sum += c; cnt += (c > 0u) ? 1u : 0u; mine = (j == x) ? c : mine; }
        if (sum == G) break;
        __builtin_amdgcn_s_sleep(1);
        if ((++sp & 255u) == 0u) { if (xb_ld(&bar[XB_TMO])) break; if (sp > XB_SPIN_CAP) { atomicAdd(&bar[XB_TMO], 1u); break; } }
    }
    nloc = mine > 0u ? mine : 1u; nx = cnt > 0u ? cnt : 1u;
}

__device__ __forceinline__ void xcd_barrier(const XcdBarrier& b) {
    asm volatile("s_waitcnt vmcnt(0)" ::: "memory");
    __syncthreads();
    if (threadIdx.x == 0) {
        unsigned* bar = b.bar;
        __builtin_amdgcn_s_waitcnt(0);
        unsigned nloc = b.st[0], nx = b.st[1];
        if (nloc == 0u) { xcd_barrier_complete(bar, b.x, nloc, nx); b.st[0] = nloc; b.st[1] = nx; }
        const unsigned old = xb_add(&bar[XB_XSUB(b.x)], 1u);
        const unsigned gen = old / nloc;
        if (old + 1u == (gen + 1u) * nloc) {
            __builtin_amdgcn_fence(__ATOMIC_RELEASE, "agent");
            asm volatile("s_waitcnt vmcnt(0)" ::: "memory");
            const unsigned og = xb_add(&bar[XB_TOP], 1u);
            const unsigned tg = og / nx;
            if (og + 1u == (tg + 1u) * nx) xb_add(&bar[XB_TOPGEN], 1u);
            else XB_SPIN(xb_ld(&bar[XB_TOPGEN]) == tg, bar);
            __builtin_amdgcn_fence(__ATOMIC_ACQUIRE, "agent");
            xb_add(&bar[XB_XGEN(b.x)], 1u);
            asm volatile("s_waitcnt vmcnt(0)" ::: "memory");
        } else {
            XB_SPIN(xb_ld(&bar[XB_XGEN(b.x)]) == gen, bar);
            __builtin_amdgcn_fence(__ATOMIC_ACQUIRE, "agent");
            asm volatile("s_waitcnt vmcnt(0)" ::: "memory");
        }
    }
    __syncthreads();
}

__global__ void __launch_bounds__(512, 2) mega_fwd(Args a) {
    __builtin_assume(__builtin_amdgcn_workitem_id_y() == 0); __builtin_assume(__builtin_amdgcn_workitem_id_z() == 0);
    extern __shared__ __attribute__((aligned(16))) unsigned char lds_raw[];
    LAS unsigned char* lds = (LAS unsigned char*)lds_raw;
    const int tid = threadIdx.x, lane = tid & 63, wave = __builtin_amdgcn_readfirstlane(tid >> 6), G = gridDim.x;
    unsigned char* ws = a.ws;
    const int lo = a.ph_lo, hi = a.ph_hi;
#ifndef PH_MASK
#define PH_MASK 0x1ff
#endif
#define IN(k) (((PH_MASK >> (k)) & 1) && lo <= (k) && (k) < hi)
#ifndef REPEAT_MASK
#define REPEAT_MASK 0
#endif
#define NREP(k) (((REPEAT_MASK >> (k)) & 1) ? 2 : 1)
    { volatile LAS unsigned* bst0 = (volatile LAS unsigned*)(lds + LDS_MISC_OFF); if (tid < 4) bst0[tid] = 0u; }
    __syncthreads();
    (void)xcd_barrier_post((unsigned*)(ws + WS_BAR), (volatile LAS unsigned*)(lds + LDS_MISC_OFF));
    if (hi > 2 * NPHASE) cg::this_grid().sync();
#define GSYNC(k) do { if (IN(k) && IN((k) + 1)) { XcdBarrier bar_; bar_.bar = (unsigned*)(ws + WS_BAR); bar_.x = xb_xcc_id(); bar_.st = (volatile LAS unsigned*)(lds + LDS_MISC_OFF); xcd_barrier(bar_); } } while (0)
    float* ssq = (float*)(ws + WS_SSQ);
    bf16_t* XB = (bf16_t*)(ws + WS_XB); bf16_t* HB = (bf16_t*)(ws + WS_H);
    bf16_t* QB = (bf16_t*)(ws + WS_Q); bf16_t* KB = (bf16_t*)(ws + WS_K); bf16_t* VB = (bf16_t*)(ws + WS_V); bf16_t* ZB = (bf16_t*)(ws + WS_Z);
    bf16_t* MIX = (bf16_t*)(ws + WS_MIX); bf16_t* PP = (bf16_t*)(ws + WS_PP); bf16_t* PB = (bf16_t*)(ws + WS_PB);

    if (IN(0)) { for (int rep = 0; rep < NREP(0); ++rep) { prologue(a, lds, tid, wave, lane, G); if (rep + 1 < NREP(0)) __syncthreads(); } }
    GSYNC(0);
    if (IN(1)) {
        for (int rep = 0; rep < NREP(1); ++rep)
        { pg8::Gemm g{XB, (const bf16_t*)(ws + WS_WGU1), M, NGU, D}; pg8::StaticOrder S; S.init(M, NGU, G, (int)blockIdx.x);
          EpiGU E{HB, ssq}; pg8::gemm_phase<EpiGU, pg8::StaticOrder, GEMM_ALIGN, GEMM_SP2>(lds, g, S, E); }
    }
    GSYNC(1);
    if (IN(2)) {
        pg8::Gemm g{HB, (const bf16_t*)(ws + WS_WD1), M, D, FF}; pg8::StaticOrder S; S.init(M, D, G, (int)blockIdx.x, PH_REV);
        EpiRes<false> E{nullptr, XB, XB, ssq + (size_t)M, 0.5f}; pg8::gemm_phase<EpiRes<false>, pg8::StaticOrder, GEMM_ALIGN, GEMM_SP2>(lds, g, S, E);
    }
    GSYNC(2);
    if (IN(3)) for (int rep = 0; rep < NREP(3); ++rep) {
        pg8::Gemm g{XB, (const bf16_t*)(ws + WS_WIN), M, NIN, D}; pg8::StaticOrder S; S.init(M, NIN, G, (int)blockIdx.x);
        EpiWin E{QB, KB, VB, ZB, ssq + (size_t)M, inp(a, 7), inp(a, 8)}; pg8::gemm_phase<EpiWin, pg8::StaticOrder, GEMM_ALIGN, GEMM_SP2>(lds, g, S, E);
    }
    GSYNC(3);
#ifndef REP_ATTN
#define REP_ATTN 1
#endif
#ifndef REP_POOL
#define REP_POOL 1
#endif
    if (IN(4)) {
        for (int rep = 0; rep < REP_ATTN; ++rep) attn_phase(lds, QB, KB, VB, inp(a, 9), inp(a, 10), MIX, tid, wave, lane, G);
        for (int rep = 0; rep < REP_POOL; ++rep) pool_phase(ZB, MIX, wave, lane, G);
    }
    GSYNC(4);
    if (IN(5)) {
        pg8::Gemm g{MIX, (const bf16_t*)(ws + WS_WOUT), M, D, D}; pg8::StaticOrder S; S.init(M, D, G, (int)blockIdx.x);
        EpiRes<false> E{nullptr, XB, XB, ssq + 2 * (size_t)M, 1.0f}; pg8::gemm_phase<EpiRes<false>, pg8::StaticOrder, GEMM_ALIGN, GEMM_SP2>(lds, g, S, E);
    }
    GSYNC(5);
#ifndef HOT_PROBE
#define HOT_PROBE 0
#endif
#ifndef NOSTORE_PROBE
#define NOSTORE_PROBE 0
#endif
    if (IN(6)) for (int rep = 0; rep < (HOT_PROBE ? 2 : NREP(6)); ++rep) {
        pg8::Gemm g{XB, (const bf16_t*)(ws + WS_WGU2), M, NGU, D}; pg8::StaticOrder S; S.init(M, NGU, G, (int)blockIdx.x, PH_REV); if (HOT_PROBE == 1 && rep == 1) S.hot = 22;
        if (HOT_PROBE == 2) {
            if (rep == 0) { g.M = M / 2; g.N = NGU / 2; g.K = 2 * D; S.init(M / 2, NGU / 2, G, (int)blockIdx.x, 0); }
            else { XcdBarrier bar_; bar_.bar = (unsigned*)(ws + WS_BAR); bar_.x = xb_xcc_id(); bar_.st = (volatile LAS unsigned*)(lds + LDS_MISC_OFF); xcd_barrier(bar_); }
        }
        EpiGU E{HB, ssq + 2 * (size_t)M}; if (NOSTORE_PROBE && rep == 1) E.nostore = 1;
        pg8::gemm_phase<EpiGU, pg8::StaticOrder, GEMM_ALIGN, GEMM_SP2>(lds, g, S, E);
    }
    GSYNC(6);
    if (IN(7)) {
        pg8::Gemm g{HB, (const bf16_t*)(ws + WS_WD2), M, D, FF}; pg8::StaticOrder S; S.init(M, D, G, (int)blockIdx.x);
        EpiRes<false> E{nullptr, XB, XB, ssq + 3 * (size_t)M, 0.5f}; pg8::gemm_phase<EpiRes<false>, pg8::StaticOrder, GEMM_ALIGN, GEMM_SP2>(lds, g, S, E);
        { pg8::Gemm g{PB, (const bf16_t*)(ws + WS_WP), M, D, PLE}; pg8::StaticOrder S; S.init(M, D, G, (int)blockIdx.x);
          EpiPP E{PP, ssq + 4 * (size_t)M, inp(a, 21)}; pg8::gemm_phase<EpiPP, pg8::StaticOrder, GEMM_ALIGN, GEMM_SP2>(lds, g, S, E); }
    }
    GSYNC(7);
#ifndef KPROBE
#define KPROBE 0
#endif
    if (IN(8)) for (int rep = (KPROBE ? 0 : 1); rep < 2; ++rep) {
        pg8::Gemm g{XB, (const bf16_t*)(ws + WS_WG), M, D, D}; pg8::StaticOrder S; S.init(M, D, G, (int)blockIdx.x, PH_REV);
        if (KPROBE && rep == 0) { S.hot = 8; if (KPROBE == 2) { g.A = HB; g.Bt = (const bf16_t*)(ws + WS_WD2); g.K = FF; } }
        EpiGate E{a.out, XB, PP, ssq + 3 * (size_t)M, ssq + 4 * (size_t)M, inp(a, 19)}; pg8::gemm_phase<EpiGate, pg8::StaticOrder, GEMM_ALIGN, GEMM_SP2>(lds, g, S, E);
    }
#undef IN
#undef GSYNC
}

extern "C" void kernel_launch(void* const* d_in, const int* in_sizes, int n_in, void* d_out, int out_size, void* d_ws, size_t ws_size, hipStream_t stream) {
    static int grid = 0;
    if (grid == 0) {
        if (n_in != 22 || out_size != M * D || ws_size < WS_END) { fprintf(stderr, "kernel_launch: unexpected shapes (n_in %d, out %d, ws %zu)\n", n_in, out_size, ws_size); grid = -1; return; }
        int dev = 0, cus = 0, per_cu = 0;
        (void)hipGetDevice(&dev); (void)hipDeviceGetAttribute(&cus, hipDeviceAttributeMultiprocessorCount, dev);
        if (hipFuncSetAttribute((const void*)mega_fwd, hipFuncAttributeMaxDynamicSharedMemorySize, LDS_BYTES) != hipSuccess) { fprintf(stderr, "kernel_launch: hipFuncSetAttribute failed\n"); grid = -1; return; }
        if (hipOccupancyMaxActiveBlocksPerMultiprocessor(&per_cu, (const void*)mega_fwd, 512, LDS_BYTES) != hipSuccess || per_cu < 1) per_cu = 1;
        (void)hipGetLastError();
        grid = cus * per_cu;
        if (grid <= 0) grid = 256;
    }
    if (grid < 0) return;
    if (hipMemsetAsync((unsigned char*)d_ws + WS_BAR, 0, XCD_BAR_WORDS * sizeof(unsigned), stream) != hipSuccess) { fprintf(stderr, "kernel_launch: memset of the barrier words failed\n"); return; }
    Args a{};
    for (int i = 0; i < 22; ++i) a.in[i] = (const float*)d_in[i];
    a.out = (float*)d_out; a.ws = (unsigned char*)d_ws;
#if MK_N_LAUNCHES == 1
    a.ph_lo = 0; a.ph_hi = NPHASE;
    void* args[] = {&a};
    hipError_t e = hipLaunchCooperativeKernel((const void*)mega_fwd, dim3(grid), dim3(512), args, LDS_BYTES, stream);
    if (e != hipSuccess) fprintf(stderr, "cooperative launch failed: %s (grid %d)\n", hipGetErrorString(e), grid);
#else
    for (int ph = 0; ph < NPHASE; ++ph) {
        a.ph_lo = ph; a.ph_hi = ph + 1;
        hipLaunchKernelGGL(mega_fwd, dim3(grid), dim3(512), LDS_BYTES, stream, a);
    }
#endif
}
```
